# Optimizing an MI355X kernel written in HIP

```python
import jax, jax.numpy as jnp
from jax import lax
import numpy as np

D_MODEL = 2048
BATCH = 4
SEQ = 4096
DEPTH = 1

HEAD_DIM = 128
GDN_HEADS = 8
GDN_WIDTH = GDN_HEADS * HEAD_DIM
GDN_CONV = 4
GDN_CHUNK = 64
MOBA_HEADS = 8
MOBA_WIDTH = MOBA_HEADS * HEAD_DIM
MOBA_BLOCK = 256
MOBA_TOPK = 3
MOBA_QCHUNK = 32
ROPE_THETA = 10000.0
EPS = 1e-6
N_BRANCH = 2

SPLIT_SIZES = [3 * GDN_WIDTH, GDN_WIDTH, GDN_HEADS, GDN_HEADS,
               3 * MOBA_WIDTH, MOBA_WIDTH, N_BRANCH * D_MODEL]
SPLIT_POINTS = [int(s) for s in np.cumsum(SPLIT_SIZES)[:-1]]
IN_COLS = int(sum(SPLIT_SIZES))

kernel_name = "hybrid_gdn_moba_gated_merge"


def rms_norm(x, w):
    xf = x.astype(jnp.float32)
    y = xf * lax.rsqrt(jnp.mean(xf * xf, axis=-1, keepdims=True) + EPS) * w.astype(jnp.float32)
    return y.astype(x.dtype)


def l2_norm(x):
    xf = x.astype(jnp.float32)
    return xf * lax.rsqrt(jnp.sum(xf * xf, axis=-1, keepdims=True) + EPS)


def causal_depthwise_conv(x, w):
    k_width, ch = w.shape
    return lax.conv_general_dilated(
        x, w[:, None, :].astype(x.dtype), window_strides=(1,), padding=[(k_width - 1, 0)],
        dimension_numbers=("NWC", "WIO", "NWC"), feature_group_count=ch)


def rope(x):
    t_len, d = x.shape[1], x.shape[3]
    inv_freq = ROPE_THETA ** (-jnp.arange(0, d, 2, dtype=jnp.float32) / d)
    ang = jnp.arange(t_len, dtype=jnp.float32)[:, None] * inv_freq[None, :]
    cos = jnp.cos(ang)[None, :, None, :]
    sin = jnp.sin(ang)[None, :, None, :]
    xf = x.astype(jnp.float32)
    x1, x2 = xf[..., : d // 2], xf[..., d // 2:]
    return jnp.concatenate([x1 * cos - x2 * sin, x2 * cos + x1 * sin], axis=-1).astype(x.dtype)


def gated_delta_rule(q, k, v, g, beta):
    b_sz, t_len, n_h, d_k = q.shape
    d_v = v.shape[-1]
    c = GDN_CHUNK
    n_c = t_len // c

    def to_chunks(t):
        return t.astype(jnp.float32).reshape(b_sz, n_c, c, n_h, -1).transpose(1, 0, 3, 2, 4)

    q = to_chunks(q) * (d_k ** -0.5)
    k = to_chunks(k)
    v = to_chunks(v)
    g = g.astype(jnp.float32).reshape(b_sz, n_c, c, n_h).transpose(1, 0, 3, 2)
    beta = beta.astype(jnp.float32).reshape(b_sz, n_c, c, n_h).transpose(1, 0, 3, 2)

    cum_g = jnp.cumsum(g, axis=-1)
    causal = jnp.tril(jnp.ones((c, c), dtype=bool))
    strict = jnp.tril(jnp.ones((c, c), dtype=bool), k=-1)
    decay_mat = jnp.exp(jnp.where(causal, cum_g[..., :, None] - cum_g[..., None, :], -jnp.inf))

    kk = jnp.einsum("nbhid,nbhjd->nbhij", k, k)
    a_mat = jnp.where(strict, beta[..., :, None] * kk * decay_mat, 0.0)
    eye = jnp.eye(c, dtype=jnp.float32)
    rhs = jnp.concatenate([v * beta[..., None], k * (beta * jnp.exp(cum_g))[..., None]], axis=-1)
    sol = lax.linalg.triangular_solve(eye + a_mat, rhs, left_side=True, lower=True,
                                      unit_diagonal=True)
    u, w = sol[..., :d_v], sol[..., d_v:]

    qk = jnp.einsum("nbhid,nbhjd->nbhij", q, k) * decay_mat
    q_dec = q * jnp.exp(cum_g)[..., None]
    k_dec = k * jnp.exp(cum_g[..., -1:] - cum_g)[..., None]
    g_last = jnp.exp(cum_g[..., -1])

    def step(state, xs):
        q_c, k_c, u_c, w_c, qk_c, gl_c = xs
        v_new = u_c - jnp.einsum("bhcd,bhde->bhce", w_c, state)
        o_c = jnp.einsum("bhcd,bhde->bhce", q_c, state) + jnp.einsum("bhij,bhje->bhie", qk_c, v_new)
        state = state * gl_c[..., None, None] + jnp.einsum("bhcd,bhce->bhde", k_c, v_new)
        return state, o_c

    s0 = jnp.zeros((b_sz, n_h, d_k, d_v), jnp.float32)
    _, o = lax.scan(step, s0, (q_dec, k_dec, u, w, qk, g_last))
    return o.transpose(1, 0, 3, 2, 4).reshape(b_sz, t_len, n_h, d_v)


def moba_attention(q, k, v):
    b_sz, t_len, n_h, d = q.shape
    bs = MOBA_BLOCK
    n_blk = -(-t_len // bs)
    pad = n_blk * bs - t_len
    n_sel = max(1, min(MOBA_TOPK, n_blk - 1))
    qc = MOBA_QCHUNK
    n_qc = t_len // qc
    scale = d ** -0.5

    q = q.transpose(0, 2, 1, 3)
    k = jnp.pad(k.transpose(0, 2, 1, 3), ((0, 0), (0, 0), (0, pad), (0, 0)))
    v = jnp.pad(v.transpose(0, 2, 1, 3), ((0, 0), (0, 0), (0, pad), (0, 0)))
    k_blocks = k.reshape(b_sz, n_h, n_blk, bs, d)
    v_blocks = v.reshape(b_sz, n_h, n_blk, bs, d)
    k_mean = jnp.mean(k_blocks.astype(jnp.float32), axis=3)

    q_blk = jnp.arange(t_len) // bs
    gate = jnp.einsum("bhtd,bhnd->bhtn", q.astype(jnp.float32), k_mean)
    gate = jnp.where(jnp.arange(n_blk)[None, :] < q_blk[:, None], gate, -jnp.inf)
    _, sel = lax.top_k(gate, n_sel)

    bi = jnp.arange(b_sz)[:, None, None, None]
    hi = jnp.arange(n_h)[None, :, None, None]

    def attend(args):
        q_c, sel_c, start = args
        pos = start + jnp.arange(qc)
        blk = start // bs
        k_own = lax.dynamic_slice_in_dim(k, blk * bs, bs, axis=2)
        v_own = lax.dynamic_slice_in_dim(v, blk * bs, bs, axis=2)
        s_own = jnp.einsum("bhqd,bhkd->bhqk", q_c, k_own).astype(jnp.float32) * scale
        s_own = jnp.where((blk * bs + jnp.arange(bs))[None, :] <= pos[:, None], s_own, -jnp.inf)
        k_sel = k_blocks[bi, hi, sel_c]
        v_sel = v_blocks[bi, hi, sel_c]
        s_sel = jnp.einsum("bhqd,bhqnkd->bhqnk", q_c, k_sel).astype(jnp.float32) * scale
        valid = jnp.arange(n_sel) < blk
        s_sel = jnp.where(valid[None, None, None, :, None], s_sel, -jnp.inf)
        s_sel = s_sel.reshape(b_sz, n_h, qc, n_sel * bs)
        p = jax.nn.softmax(jnp.concatenate([s_sel, s_own], axis=-1), axis=-1)
        p_sel = p[..., : n_sel * bs].reshape(b_sz, n_h, qc, n_sel, bs).astype(v.dtype)
        p_own = p[..., n_sel * bs:].astype(v.dtype)
        return (jnp.einsum("bhqnk,bhqnkd->bhqd", p_sel, v_sel)
                + jnp.einsum("bhqk,bhkd->bhqd", p_own, v_own))

    q_chunks = q.reshape(b_sz, n_h, n_qc, qc, d).transpose(2, 0, 1, 3, 4)
    sel_chunks = sel.reshape(b_sz, n_h, n_qc, qc, n_sel).transpose(2, 0, 1, 3, 4)
    starts = jnp.arange(n_qc, dtype=jnp.int32) * qc
    o = lax.map(attend, (q_chunks, sel_chunks, starts))
    return o.transpose(1, 0, 3, 2, 4).reshape(b_sz, t_len, n_h, d)


def setup_inputs(seed: int = 0) -> dict:
    key = jax.random.key(seed)
    ks = jax.random.split(key, 14)
    f32 = jnp.float32
    x = jax.random.normal(ks[0], (BATCH, SEQ, D_MODEL), f32)
    norm_w = 1.0 + 0.02 * jax.random.normal(ks[1], (DEPTH, D_MODEL), f32)
    w_in = jax.random.normal(ks[2], (DEPTH, D_MODEL, IN_COLS), f32) * D_MODEL ** -0.5
    gdn_conv_w = jax.random.normal(ks[3], (DEPTH, GDN_CONV, 3 * GDN_WIDTH), f32) * GDN_CONV ** -0.5
    gdn_a_log = jnp.log(jax.random.uniform(ks[4], (DEPTH, GDN_HEADS), f32, 1.0, 16.0))
    dt = jnp.exp(jax.random.uniform(ks[5], (DEPTH, GDN_HEADS), f32, np.log(1e-3), np.log(1e-1)))
    gdn_dt_bias = dt + jnp.log(-jnp.expm1(-dt))
    gdn_norm_w = 1.0 + 0.02 * jax.random.normal(ks[6], (DEPTH, HEAD_DIM), f32)
    moba_q_norm_w = 1.0 + 0.02 * jax.random.normal(ks[7], (DEPTH, HEAD_DIM), f32)
    moba_k_norm_w = 1.0 + 0.02 * jax.random.normal(ks[8], (DEPTH, HEAD_DIM), f32)
    w_out_gdn = jax.random.normal(ks[9], (DEPTH, GDN_WIDTH, D_MODEL), f32) * GDN_WIDTH ** -0.5
    w_out_moba = jax.random.normal(ks[10], (DEPTH, MOBA_WIDTH, D_MODEL), f32) * MOBA_WIDTH ** -0.5
    w_o = jax.random.normal(ks[11], (DEPTH, D_MODEL, D_MODEL), f32) * D_MODEL ** -0.5
    return {"x": x, "norm_w": norm_w, "w_in": w_in, "gdn_conv_w": gdn_conv_w,
            "gdn_a_log": gdn_a_log, "gdn_dt_bias": gdn_dt_bias, "gdn_norm_w": gdn_norm_w,
            "moba_q_norm_w": moba_q_norm_w, "moba_k_norm_w": moba_k_norm_w,
            "w_out_gdn": w_out_gdn, "w_out_moba": w_out_moba, "w_o": w_o}


def reference(x, norm_w, w_in, gdn_conv_w, gdn_a_log, gdn_dt_bias, gdn_norm_w,
              moba_q_norm_w, moba_k_norm_w, w_out_gdn, w_out_moba, w_o):
    b_sz, t_len, _ = x.shape
    for l in range(DEPTH):
        h = rms_norm(x, norm_w[l])
        proj = jnp.einsum("btd,dc->btc", h, w_in[l])
        gdn_qkv, gdn_z, gdn_b, gdn_a, moba_qkv, moba_z, gates = jnp.split(proj, SPLIT_POINTS, axis=-1)

        qkv = jax.nn.silu(causal_depthwise_conv(gdn_qkv, gdn_conv_w[l]))
        qa, ka, va = jnp.split(qkv, 3, axis=-1)
        qa = l2_norm(qa.reshape(b_sz, t_len, GDN_HEADS, HEAD_DIM))
        ka = l2_norm(ka.reshape(b_sz, t_len, GDN_HEADS, HEAD_DIM))
        va = va.reshape(b_sz, t_len, GDN_HEADS, HEAD_DIM)
        beta = jax.nn.sigmoid(gdn_b.astype(jnp.float32))
        g = -jnp.exp(gdn_a_log[l].astype(jnp.float32)) * jax.nn.softplus(
            gdn_a.astype(jnp.float32) + gdn_dt_bias[l].astype(jnp.float32))
        oa = gated_delta_rule(qa, ka, va, g, beta)
        oa = rms_norm(oa, gdn_norm_w[l]).astype(x.dtype)
        oa = oa.reshape(b_sz, t_len, GDN_WIDTH) * jax.nn.silu(gdn_z)
        y_gdn = jnp.einsum("btc,cd->btd", oa, w_out_gdn[l])

        qb, kb, vb = jnp.split(moba_qkv, 3, axis=-1)
        qb = rope(rms_norm(qb.reshape(b_sz, t_len, MOBA_HEADS, HEAD_DIM), moba_q_norm_w[l]))
        kb = rope(rms_norm(kb.reshape(b_sz, t_len, MOBA_HEADS, HEAD_DIM), moba_k_norm_w[l]))
        vb = vb.reshape(b_sz, t_len, MOBA_HEADS, HEAD_DIM)
        ob = moba_attention(qb, kb, vb).reshape(b_sz, t_len, MOBA_WIDTH) * jax.nn.silu(moba_z)
        y_moba = jnp.einsum("btc,cd->btd", ob, w_out_moba[l])

        g_gdn, g_moba = jnp.split(gates, N_BRANCH, axis=-1)
        merged = jax.nn.sigmoid(g_gdn) * y_gdn + jax.nn.sigmoid(g_moba) * y_moba
        x = x + jnp.einsum("btd,de->bte", merged, w_o[l])
    return x
```

```cpp
#include <hip/hip_runtime.h>
#include <hip/hip_cooperative_groups.h>
#include <cstdio>
namespace cg = cooperative_groups;
namespace pg8 {
#define PG8_LAS __attribute__((address_space(3)))
typedef unsigned short bf16_t;
typedef short bf16x8 __attribute__((ext_vector_type(8)));
typedef float f32x4 __attribute__((ext_vector_type(4)));
typedef unsigned u32x4 __attribute__((ext_vector_type(4)));
constexpr int BM = 256, BK = 64, HALF = 128, HTB = HALF * BK * 2  , STAGE_BYTES = 8 * HTB, NXCD = 8, WGM = 8;

__host__ __device__ __forceinline__ int lds_byte(int r, int c) { const int st = (r >> 4) * 2 + (c >> 5), rr = r & 15, cc = c & 31, ob = rr * 64 + cc * 2; return st * 1024 + (ob ^ (((ob >> 9) & 1) << 5)); }
__host__ __device__ __forceinline__ void stage_rc(int b, int& R, int& C) { const int st = b / 1024, sb = b % 1024, swz = sb ^ (((sb >> 9) & 1) << 5); R = (st >> 1) * 16 + swz / 64; C = (st & 1) * 32 + (swz % 64) / 2; }
__host__ __device__ __forceinline__ int perm32(int rho) { const int n = rho >> 4, i = rho & 15; return 8 * (i >> 2) + 4 * n + (i & 3); }

struct Unit { int pm, pn; };
struct Gemm { const bf16_t* A; const bf16_t* Bt; int M, N, K; };

struct StaticOrder {
    int nM, nN, nwg, G, c;
    __host__ __device__ void init(int M, int N, int G_, int c_) { nM = M / BM; nN = N / BM; nwg = nM * nN; G = G_; c = c_; }
    __host__ __device__ bool next(int i, Unit& u) const {
        const long L = (long)i * G + c; if (L >= nwg) return false;
        int wgid = (int)L; { const int q = nwg / NXCD, r = nwg % NXCD, xcd = wgid % NXCD, off = wgid / NXCD; wgid = (xcd < r ? xcd * (q + 1) : r * (q + 1) + (xcd - r) * q) + off; }
        const int nig = WGM * nN, gid = wgid / nig, fm = gid * WGM, gsz = (nM - fm) < WGM ? (nM - fm) : WGM;
        u.pm = fm + ((wgid % nig) % gsz); u.pn = (wgid % nig) / gsz; return true;
    }
    __device__ __forceinline__ void a_ready(const Unit&) const {}
    __device__ __forceinline__ void done(const Unit&) const {}
};
typedef __bf16 bf16v2_t __attribute__((ext_vector_type(2)));
__device__ __forceinline__ unsigned cvt_pk_bf16(float lo, float hi) { bf16v2_t v; v.x = (__bf16)lo; v.y = (__bf16)hi; return __builtin_bit_cast(unsigned, v); }
template <class Epi, class Sched, bool STAMP = false>
__device__ __forceinline__ void gemm_phase(PG8_LAS unsigned char* lds, const Gemm g, const Sched& S, const Epi& E, unsigned long long* stamps) {
    const int tid = threadIdx.x, wid = __builtin_amdgcn_readfirstlane(tid >> 6), lane = tid & 63, wr = wid >> 2, wc = wid & 3, fr = lane & 15, fq = lane >> 4;
    const int K = g.K, nt = K / BK;
    int ts_lo = 0, ts_hi = 0, nts = 0; const unsigned long long rt_entry = STAMP ? (unsigned long long)wall_clock64() : 0ull;
#define PG8_STAMP() do { if (STAMP && wid == 0 && nts < 64) { const unsigned long long _c = (unsigned long long)clock64(); \
        ts_lo = (lane == nts) ? (int)(unsigned)_c : ts_lo; ts_hi = (lane == nts) ? (int)(unsigned)(_c >> 32) : ts_hi; ++nts; } } while (0)
    PG8_STAMP();
    unsigned voffA[2], voffB[2];
#pragma unroll
    for (int i = 0; i < 2; ++i) { int R, C; stage_rc(tid * 16 + i * 8192, R, C); const int Rb = Epi::PERM ? ((R & ~31) + perm32(R & 31)) : R;
        voffA[i] = (unsigned)(R * K + C) * 2u; voffB[i] = (unsigned)(Rb * K + C) * 2u; }
    const size_t kstep = (size_t)(BK * 2);
    const size_t hstep = (size_t)HALF * K * 2;
    const size_t tstep = 2 * hstep;
    const unsigned ldsw = (unsigned)wid * 1024u;
    const int aoff = lds_byte(wr * 64 + fr, fq * 8), boff = lds_byte(wc * 32 + fr, fq * 8);
#define PG8_SA(b, h) (((b) * 2 + (h)) * HTB)
#define PG8_SB(b, h) ((4 + (b) * 2 + (h)) * HTB)
#define PG8_STAGE(bufoff, gbase, voff) do { _Pragma("unroll") for (int _i = 0; _i < 2; ++_i) \
        __builtin_amdgcn_global_load_lds((const unsigned*)((const char*)(gbase) + (voff)[_i]), (PG8_LAS unsigned*)(lds + (bufoff) + ldsw + _i * 8192), 16, 0, 0); } while (0)
#define PG8_LDA(dst, b, h) do { _Pragma("unroll") for (int m = 0; m < 4; ++m) _Pragma("unroll") for (int k = 0; k < 2; ++k) dst[m][k] = *(const PG8_LAS bf16x8*)(lds + PG8_SA(b, h) + aoff + m * 2048 + k * 1024); } while (0)
#define PG8_LDB(dst, b, h) do { _Pragma("unroll") for (int n = 0; n < 2; ++n) _Pragma("unroll") for (int k = 0; k < 2; ++k) dst[n][k] = *(const PG8_LAS bf16x8*)(lds + PG8_SB(b, h) + boff + n * 2048 + k * 1024); } while (0)
#define PG8_MMA(ai, bj, At, Bt) do { __builtin_amdgcn_s_setprio(1); _Pragma("unroll") for (int m = 0; m < 4; ++m) _Pragma("unroll") for (int n = 0; n < 2; ++n) _Pragma("unroll") for (int k = 0; k < 2; ++k) \
        acc[ai][bj][m][n] = __builtin_amdgcn_mfma_f32_16x16x32_bf16(Bt[n][k], At[m][k], acc[ai][bj][m][n], 0, 0, 0); __builtin_amdgcn_s_setprio(0); } while (0)
#define PG8_WAIT_V(n) asm volatile("s_waitcnt vmcnt(" #n ")" ::: "memory")
#define PG8_WAIT_L(n) asm volatile("s_waitcnt lgkmcnt(" #n ")" ::: "memory")
#define PG8_BAR __builtin_amdgcn_s_barrier()
#define PG8_SCHED __builtin_amdgcn_sched_barrier(0)
    Unit cur, nxt; int ui = 0;
    if (!S.next(0, cur)) return;
    f32x4 acc[2][2][4][2];
#pragma unroll
    for (int a = 0; a < 2; ++a)
#pragma unroll
        for (int b = 0; b < 2; ++b)
#pragma unroll
            for (int m = 0; m < 4; ++m)
#pragma unroll
                for (int n = 0; n < 2; ++n) acc[a][b][m][n] = (f32x4){0.f, 0.f, 0.f, 0.f};
    bf16x8 At[4][2], B0[2][2], B1[2][2];
    const char* cA = (const char*)g.A + (size_t)cur.pm * tstep; const char* cB = (const char*)g.Bt + (size_t)cur.pn * tstep;
    S.a_ready(cur);
    PG8_STAGE(PG8_SB(0, 0), cB, voffB); PG8_STAGE(PG8_SA(0, 0), cA, voffA); PG8_STAGE(PG8_SB(0, 1), cB + hstep, voffB); PG8_STAGE(PG8_SA(0, 1), cA + hstep, voffA);
    if (wr == 1) PG8_BAR;
    PG8_WAIT_V(4); PG8_BAR;
    PG8_STAGE(PG8_SB(1, 0), cB + kstep, voffB); PG8_STAGE(PG8_SA(1, 0), cA + kstep, voffA); PG8_STAGE(PG8_SB(1, 1), cB + hstep + kstep, voffB);
    PG8_WAIT_V(6); PG8_BAR;
    PG8_STAMP();
    for (;;) {
        const bool has_next = S.next(ui + 1, nxt);
        const char* nA = has_next ? (const char*)g.A + (size_t)nxt.pm * tstep : cA; const char* nB = has_next ? (const char*)g.Bt + (size_t)nxt.pn * tstep : cB;
        for (int t = 0; t < nt; t += 2) {
            const bool last = (t == nt - 2);
            const char* a1 = cA + (size_t)(t + 1) * kstep;
            const char* a2 = last ? nA : cA + (size_t)(t + 2) * kstep; const char* b2 = last ? nB : cB + (size_t)(t + 2) * kstep;
            const char* a3 = a2 + kstep; const char* b3 = b2 + kstep;
            if (last && has_next) S.a_ready(nxt);
            PG8_LDB(B0, 0, 0); PG8_SCHED; PG8_LDA(At, 0, 0); PG8_STAGE(PG8_SA(1, 1), a1 + hstep, voffA);
            PG8_WAIT_L(8); PG8_BAR; PG8_WAIT_L(0); PG8_MMA(0, 0, At, B0); PG8_BAR; PG8_SCHED;
            PG8_LDB(B1, 0, 1); PG8_STAGE(PG8_SB(0, 0), b2, voffB);
            PG8_BAR; PG8_WAIT_L(0); PG8_MMA(0, 1, At, B1); PG8_BAR;
            PG8_LDA(At, 0, 1); PG8_STAGE(PG8_SA(0, 0), a2, voffA);
            PG8_BAR; PG8_WAIT_L(0); PG8_MMA(1, 0, At, B0); PG8_BAR; PG8_SCHED;
            PG8_STAGE(PG8_SB(0, 1), b2 + hstep, voffB);
            PG8_WAIT_V(6); PG8_BAR; PG8_MMA(1, 1, At, B1); PG8_BAR;
            PG8_LDB(B0, 1, 0); PG8_SCHED; PG8_LDA(At, 1, 0); PG8_STAGE(PG8_SA(0, 1), a2 + hstep, voffA);
            PG8_WAIT_L(8); PG8_BAR; PG8_WAIT_L(0); PG8_MMA(0, 0, At, B0); PG8_BAR; PG8_SCHED;
            PG8_LDB(B1, 1, 1); PG8_STAGE(PG8_SB(1, 0), b3, voffB);
            PG8_BAR; PG8_WAIT_L(0); PG8_MMA(0, 1, At, B1); PG8_BAR;
            PG8_LDA(At, 1, 1); PG8_STAGE(PG8_SA(1, 0), a3, voffA);
            PG8_BAR; PG8_WAIT_L(0); PG8_MMA(1, 0, At, B0); PG8_BAR; PG8_SCHED;
            PG8_STAGE(PG8_SB(1, 1), b3 + hstep, voffB);
            PG8_WAIT_V(6); PG8_BAR; PG8_MMA(1, 1, At, B1); PG8_BAR;
        }
        PG8_STAMP();
        if constexpr (!Epi::AFTER_DRAIN) { E(acc, cur, wr, wc, fr, fq); S.done(cur); }
        PG8_STAMP();
        if (!has_next) break;
#pragma unroll
        for (int a = 0; a < 2; ++a)
#pragma unroll
            for (int b = 0; b < 2; ++b)
#pragma unroll
                for (int m = 0; m < 4; ++m)
#pragma unroll
                    for (int n = 0; n < 2; ++n) acc[a][b][m][n] = (f32x4){0.f, 0.f, 0.f, 0.f};
        cur = nxt; cA = nA; cB = nB; ++ui;
    }
    PG8_WAIT_V(0);
    if (wr == 0) PG8_BAR;
    PG8_BAR;
    if constexpr (Epi::AFTER_DRAIN) { E.fused(acc, cur, wr, wc, fr, fq, lds, wid, lane); S.done(cur); }
    PG8_STAMP();
    if (STAMP && wid == 0) { stamps[lane] = lane < nts ? (((unsigned long long)(unsigned)ts_hi << 32) | (unsigned)ts_lo) : 0ull;
        if (lane == 62) stamps[62] = rt_entry; if (lane == 63) stamps[63] = (unsigned long long)wall_clock64(); }
#undef PG8_STAMP
#undef PG8_SA
#undef PG8_SB
#undef PG8_STAGE
#undef PG8_LDA
#undef PG8_LDB
#undef PG8_MMA
#undef PG8_WAIT_V
#undef PG8_WAIT_L
#undef PG8_BAR
#undef PG8_SCHED
}
}
#ifndef DBG
#define DBG 0
#endif
using pg8::bf16_t; using pg8::bf16x8; using pg8::f32x4; using pg8::u32x4; using pg8::cvt_pk_bf16;
typedef unsigned u32x2 __attribute__((ext_vector_type(2)));

constexpr int NTOK = 16384, DM = 2048, SEQ = 4096, NH = 8, HD = 128, INC = 12304;
constexpr float EPSF = 1e-6f;
constexpr size_t MIB = 1048576;
constexpr size_t SEC = (size_t)NTOK * 1024;

struct Params {
    const float *x, *norm_w, *w_in, *conv_w, *a_log, *dt_bias, *gdn_norm_w, *qn_w, *kn_w, *w_out_gdn, *w_out_moba, *w_o;
    float* out; unsigned char* ws;
};

__device__ __forceinline__ bf16_t* P_sec(const Params& p, int s) { return (bf16_t*)p.ws + (size_t)s * SEC; }
__device__ __forceinline__ bf16_t* WgT(const Params& p) { return (bf16_t*)(p.ws + 384 * MIB); }
__device__ __forceinline__ bf16_t* WmT(const Params& p) { return (bf16_t*)(p.ws + 388 * MIB); }
__device__ __forceinline__ bf16_t* WoT(const Params& p) { return (bf16_t*)(p.ws + 392 * MIB); }
__device__ __forceinline__ float* BETA(const Params& p) { return (float*)(p.ws + 400 * MIB); }
__device__ __forceinline__ float* GLOG(const Params& p) { return (float*)(p.ws + 400 * MIB + 524288); }
__device__ __forceinline__ float* KMEAN(const Params& p) { return (float*)(p.ws + 401 * MIB); }
__device__ __forceinline__ float* GLAST(const Params& p) { return (float*)(p.ws + 401 * MIB + 524288); }
__device__ __forceinline__ bf16_t* QKB(const Params& p) { return (bf16_t*)(p.ws + 402 * MIB); }
__device__ __forceinline__ bf16_t* OB(const Params& p) { return (bf16_t*)(p.ws + 418 * MIB); }
__device__ __forceinline__ bf16_t* VT(const Params& p) { return (bf16_t*)(p.ws + 450 * MIB); }
__device__ __forceinline__ float* OGDN(const Params& p) { return (float*)p.ws; }
__device__ __forceinline__ bf16_t* OA(const Params& p) { return P_sec(p, 2); }
__device__ __forceinline__ bf16_t* MERGED(const Params& p) { return P_sec(p, 4); }
__device__ __forceinline__ bf16_t* HB(const Params& p) { return (bf16_t*)p.out; }
__device__ __forceinline__ bf16_t* WinT(const Params& p) { return (bf16_t*)((unsigned char*)p.out + 64 * MIB); }
__device__ __forceinline__ bf16_t* UB(const Params& p) { return (bf16_t*)p.out; }
__device__ __forceinline__ bf16_t* WB(const Params& p) { return (bf16_t*)((unsigned char*)p.out + 32 * MIB); }
__device__ __forceinline__ bf16_t* QDB(const Params& p) { return (bf16_t*)((unsigned char*)p.out + 64 * MIB); }
__device__ __forceinline__ bf16_t* KDT(const Params& p) { return (bf16_t*)((unsigned char*)p.out + 96 * MIB); }

__device__ __forceinline__ float bf2f(unsigned short b) { return __uint_as_float(((unsigned)b) << 16); }
__device__ __forceinline__ float bflo(unsigned w) { return __uint_as_float(w << 16); }
__device__ __forceinline__ float bfhi(unsigned w) { return __uint_as_float(w & 0xffff0000u); }
__device__ __forceinline__ bf16x8 as_bf8(u32x4 v) { return __builtin_bit_cast(bf16x8, v); }
__device__ __forceinline__ float sigmoidf_(float v) { return 1.0f / (1.0f + __expf(-v)); }
__device__ __forceinline__ float siluf_(float v) { return v / (1.0f + __expf(-v)); }
__device__ __forceinline__ void unpack8(u32x4 v, float* f) { f[0] = bflo(v.x); f[1] = bfhi(v.x); f[2] = bflo(v.y); f[3] = bfhi(v.y); f[4] = bflo(v.z); f[5] = bfhi(v.z); f[6] = bflo(v.w); f[7] = bfhi(v.w); }
__device__ __forceinline__ u32x4 pack8(const float* f) { u32x4 w; w.x = cvt_pk_bf16(f[0], f[1]); w.y = cvt_pk_bf16(f[2], f[3]); w.z = cvt_pk_bf16(f[4], f[5]); w.w = cvt_pk_bf16(f[6], f[7]); return w; }
#define MFMA16(a, b, c) __builtin_amdgcn_mfma_f32_16x16x32_bf16((a), (b), (c), 0, 0, 0)

struct Epi1 {
    static constexpr bool PERM = true, AFTER_DRAIN = false;
    bf16_t* P;
    __device__ __forceinline__ void operator()(const f32x4 (&acc)[2][2][4][2], const pg8::Unit& u, int wr, int wc, int fr, int fq) const {
        const int row0 = u.pm * 256 + wr * 64 + fr; int colt = u.pn * 256; bf16_t* base = P + (size_t)(colt >> 10) * SEC; colt &= 1023;
        const int col0 = colt + wc * 32 + 8 * fq;
#pragma unroll
        for (int ai = 0; ai < 2; ++ai)
#pragma unroll
            for (int m = 0; m < 4; ++m) { bf16_t* rowp = base + (size_t)(row0 + ai * 128 + m * 16) * 1024 + col0;
#pragma unroll
                for (int bj = 0; bj < 2; ++bj) { const f32x4 v0 = acc[ai][bj][m][0], v1 = acc[ai][bj][m][1];
                    u32x4 w; w.x = cvt_pk_bf16(v0[0], v0[1]); w.y = cvt_pk_bf16(v0[2], v0[3]); w.z = cvt_pk_bf16(v1[0], v1[1]); w.w = cvt_pk_bf16(v1[2], v1[3]);
                    *(u32x4*)(rowp + bj * 128) = w; } }
    }
};
template <int PASS> struct Epi2 {
    static constexpr bool PERM = true, AFTER_DRAIN = false;
    bf16_t* M; const bf16_t* G;
    __device__ __forceinline__ void operator()(const f32x4 (&acc)[2][2][4][2], const pg8::Unit& u, int wr, int wc, int fr, int fq) const {
        const int row0 = u.pm * 256 + wr * 64 + fr; const int colt = u.pn * 256;
        const bf16_t* gb = G + (size_t)(colt >> 10) * SEC; const int gcol0 = (colt & 1023) + wc * 32 + 8 * fq; const int col0 = colt + wc * 32 + 8 * fq;
#pragma unroll
        for (int ai = 0; ai < 2; ++ai)
#pragma unroll
            for (int m = 0; m < 4; ++m) { const int row = row0 + ai * 128 + m * 16;
#pragma unroll
                for (int bj = 0; bj < 2; ++bj) { const f32x4 v0 = acc[ai][bj][m][0], v1 = acc[ai][bj][m][1];
                    float g[8]; unpack8(*(const u32x4*)(gb + (size_t)row * 1024 + gcol0 + bj * 128), g);
                    float o[8];
#pragma unroll
                    for (int e = 0; e < 4; ++e) { o[e] = sigmoidf_(g[e]) * v0[e]; o[4 + e] = sigmoidf_(g[4 + e]) * v1[e]; }
                    bf16_t* mp = M + (size_t)row * 2048 + col0 + bj * 128;
                    if (PASS) { float old[8]; unpack8(*(const u32x4*)mp, old);
#pragma unroll
                        for (int e = 0; e < 8; ++e) o[e] += old[e]; }
                    *(u32x4*)mp = pack8(o); } }
    }
};
struct Epi3 {
    static constexpr bool PERM = false, AFTER_DRAIN = false;
    float* O; const float* X;
    __device__ __forceinline__ void operator()(const f32x4 (&acc)[2][2][4][2], const pg8::Unit& u, int wr, int wc, int fr, int fq) const {
        const int row0 = u.pm * 256 + wr * 64 + fr, col0 = u.pn * 256 + wc * 32 + 4 * fq;
#pragma unroll
        for (int ai = 0; ai < 2; ++ai)
#pragma unroll
            for (int m = 0; m < 4; ++m) { const size_t ro = (size_t)(row0 + ai * 128 + m * 16) * DM + col0;
#pragma unroll
                for (int bj = 0; bj < 2; ++bj)
#pragma unroll
                    for (int n = 0; n < 2; ++n) { const f32x4 xv = *(const f32x4*)(X + ro + bj * 128 + n * 16); *(f32x4*)(O + ro + bj * 128 + n * 16) = acc[ai][bj][m][n] + xv; } }
    }
};

__device__ __forceinline__ float wave_sum(float v) {
#pragma unroll
    for (int d = 32; d >= 1; d >>= 1) v += __shfl_xor(v, d, 64);
    return v;
}
__device__ void p0_rows(const Params& p) {
    const int wid = threadIdx.x >> 6, lane = threadIdx.x & 63;
    bf16_t* H = HB(p);
    for (int row = blockIdx.x * 8 + wid; row < NTOK; row += gridDim.x * 8) {
        const float4* xr = (const float4*)(p.x + (size_t)row * DM);
        float4 v[8]; float ss = 0.f;
#pragma unroll
        for (int i = 0; i < 8; ++i) { v[i] = xr[i * 64 + lane]; ss += v[i].x * v[i].x + v[i].y * v[i].y + v[i].z * v[i].z + v[i].w * v[i].w; }
        ss = wave_sum(ss);
        const float rstd = rsqrtf(ss * (1.0f / DM) + EPSF);
#pragma unroll
        for (int i = 0; i < 8; ++i) { const float4 w = ((const float4*)p.norm_w)[i * 64 + lane];
            u32x2 o; o.x = cvt_pk_bf16(v[i].x * rstd * w.x, v[i].y * rstd * w.y); o.y = cvt_pk_bf16(v[i].z * rstd * w.z, v[i].w * rstd * w.w);
            *(u32x2*)(H + (size_t)row * DM + i * 256 + lane * 4) = o; }
    }
}
__device__ void transpose_tile(const float* src, int K, int N, int kt, int nt, bf16_t* dst, int mode, float* tile) {
    const int tid = threadIdx.x;
#pragma unroll
    for (int e = tid; e < 1024; e += 512) { const int r = e >> 4, c4 = e & 15; const int n = nt * 64 + c4 * 4; float4 v = make_float4(0.f, 0.f, 0.f, 0.f);
        if (n < N) v = *(const float4*)(src + (size_t)(kt * 64 + r) * N + n);
        float* t = tile + r * 65 + c4 * 4; t[0] = v.x; t[1] = v.y; t[2] = v.z; t[3] = v.w; }
    __syncthreads();
    { const int n = tid >> 3, kg = tid & 7; const int ng = nt * 64 + n;
      if (ng < N) { int dn = ng; if (mode == 1) dn = ng < 4096 ? ng : (ng < 4112 ? 12288 + (ng - 4096) : ng - 16);
          float f[8];
#pragma unroll
          for (int j = 0; j < 8; ++j) f[j] = tile[(kg * 8 + j) * 65 + n];
          *(u32x4*)(dst + (size_t)dn * K + kt * 64 + kg * 8) = pack8(f); } }
    __syncthreads();
}
__device__ void p0_transposes(const Params& p, float* tile) {
    const int n0 = 32 * 193, n1 = n0 + 512, n2 = n1 + 512, n3 = n2 + 1024;
    for (int t = blockIdx.x; t < n3; t += gridDim.x) {
        if (t < n0) transpose_tile(p.w_in, 2048, INC, t / 193, t % 193, WinT(p), 1, tile);
        else if (t < n1) { const int u = t - n0; transpose_tile(p.w_out_gdn, 1024, 2048, u / 32, u % 32, WgT(p), 0, tile); }
        else if (t < n2) { const int u = t - n1; transpose_tile(p.w_out_moba, 1024, 2048, u / 32, u % 32, WmT(p), 0, tile); }
        else { const int u = t - n2; transpose_tile(p.w_o, 2048, 2048, u / 32, u % 32, WoT(p), 0, tile); }
    }
}

__device__ void p1_skinny(const Params& p, float* red) {
    const int wid = threadIdx.x >> 6, lane = threadIdx.x & 63, fr = lane & 15, g = lane >> 4;
    const bf16_t* H = HB(p); const bf16_t* Bt = WinT(p) + (size_t)12288 * 2048;
    for (int it = blockIdx.x; it < NTOK / 64; it += gridDim.x) {
        const int rt = wid & 3, kh = wid >> 2; const int row = it * 64 + rt * 16 + fr;
        const bf16_t* ap = H + (size_t)row * DM + kh * 1024 + g * 8; const bf16_t* bp = Bt + (size_t)fr * DM + kh * 1024 + g * 8;
        f32x4 acc = {0.f, 0.f, 0.f, 0.f};
#pragma unroll 8
        for (int ks = 0; ks < 32; ++ks) { const bf16x8 a = as_bf8(*(const u32x4*)(ap + ks * 32)); const bf16x8 b = as_bf8(*(const u32x4*)(bp + ks * 32)); acc = MFMA16(a, b, acc); }
        if (kh == 1) *(f32x4*)(red + (rt * 64 + lane) * 4) = acc;
        __syncthreads();
        if (kh == 0) { const f32x4 o = *(const f32x4*)(red + (rt * 64 + lane) * 4); acc += o;
#pragma unroll
            for (int r = 0; r < 4; ++r) { const int tok = it * 64 + rt * 16 + g * 4 + r; const float v = acc[r];
                if (fr < 8) BETA(p)[tok * 8 + fr] = sigmoidf_(v);
                else { const int hh = fr - 8; const float z = v + p.dt_bias[hh]; const float sp = z > 20.f ? z : log1pf(expf(z)); GLOG(p)[tok * 8 + hh] = -expf(p.a_log[hh]) * sp; } } }
        __syncthreads();
    }
}

__device__ void p2_gdn_prep(const Params& p, unsigned char* lds) {
    float* kf = (float*)lds; float* vf = (float*)(lds + 32768); bf16_t* qb = (bf16_t*)(lds + 65536); bf16_t* kb = (bf16_t*)(lds + 82944);
    float* Af = (float*)(lds + 100352); float* cum = (float*)(lds + 116736); float* sbeta = (float*)(lds + 116992); float* fac = (float*)(lds + 117248);
    const int tid = threadIdx.x, wid = tid >> 6, lane = tid & 63, fr = lane & 15, g = lane >> 4;
    const float scale = 0.08838834764831845f;
    for (int cid = blockIdx.x; cid < 2048; cid += gridDim.x) {
        const int bh = cid >> 6, n = cid & 63, b = bh >> 3, h = bh & 7; const int tok0 = b * SEQ + n * 64;
        if (wid == 0) { float v = GLOG(p)[(tok0 + lane) * 8 + h]; const float be = BETA(p)[(tok0 + lane) * 8 + h];
#pragma unroll
            for (int d = 1; d < 64; d <<= 1) { const float t = __shfl_up(v, d, 64); if (lane >= d) v += t; }
            cum[lane] = v; sbeta[lane] = be; fac[lane] = be * __expf(v); }
        __syncthreads();
        { const int tok = tid >> 3, c0 = (tid & 7) * 16; const float cumt = cum[tok], cuml = cum[63];
#pragma unroll
          for (int s = 0; s < 3; ++s) {
              float a[16];
#pragma unroll
              for (int e = 0; e < 16; ++e) a[e] = 0.f;
              const bf16_t* src = P_sec(p, s) + h * 128 + c0; const float* cw = p.conv_w + s * 1024 + h * 128 + c0;
#pragma unroll
              for (int j = 0; j < 4; ++j) { const int pos = n * 64 + tok - 3 + j;
                  if (pos >= 0) { const bf16_t* rp = src + (size_t)(b * SEQ + pos) * 1024; float xv[16]; unpack8(*(const u32x4*)rp, xv); unpack8(*(const u32x4*)(rp + 8), xv + 8);
#pragma unroll
                      for (int e4 = 0; e4 < 4; ++e4) { const float4 w = *(const float4*)(cw + j * 3072 + e4 * 4);
                          a[e4 * 4 + 0] += w.x * xv[e4 * 4 + 0]; a[e4 * 4 + 1] += w.y * xv[e4 * 4 + 1]; a[e4 * 4 + 2] += w.z * xv[e4 * 4 + 2]; a[e4 * 4 + 3] += w.w * xv[e4 * 4 + 3]; } } }
              float ss = 0.f;
#pragma unroll
              for (int e = 0; e < 16; ++e) { a[e] = siluf_(a[e]); ss += a[e] * a[e]; }
              if (s < 2) { ss += __shfl_xor(ss, 1, 64); ss += __shfl_xor(ss, 2, 64); ss += __shfl_xor(ss, 4, 64); const float rn = rsqrtf(ss + EPSF);
#pragma unroll
                  for (int e = 0; e < 16; ++e) a[e] *= rn; }
              if (s == 0) { *(u32x4*)(qb + tok * 136 + c0) = pack8(a); *(u32x4*)(qb + tok * 136 + c0 + 8) = pack8(a + 8);
                  const float f = scale * __expf(cumt); float d[16];
#pragma unroll
                  for (int e = 0; e < 16; ++e) d[e] = a[e] * f;
                  bf16_t* dp = QDB(p) + ((size_t)cid * 64 + tok) * 128 + c0; *(u32x4*)dp = pack8(d); *(u32x4*)(dp + 8) = pack8(d + 8); }
              else if (s == 1) { *(u32x4*)(kb + tok * 136 + c0) = pack8(a); *(u32x4*)(kb + tok * 136 + c0 + 8) = pack8(a + 8);
#pragma unroll
                  for (int e4 = 0; e4 < 4; ++e4) *(float4*)(kf + tok * 128 + c0 + e4 * 4) = make_float4(a[e4 * 4], a[e4 * 4 + 1], a[e4 * 4 + 2], a[e4 * 4 + 3]); }
              else {
#pragma unroll
                  for (int e4 = 0; e4 < 4; ++e4) *(float4*)(vf + tok * 128 + c0 + e4 * 4) = make_float4(a[e4 * 4], a[e4 * 4 + 1], a[e4 * 4 + 2], a[e4 * 4 + 3]); }
          }
          (void)cuml; }
        __syncthreads();
        { const int mat = wid >> 2, mi = wid & 3; const bf16_t* xb = mat ? qb : kb;
          bf16x8 xfrag[4];
#pragma unroll
          for (int ks = 0; ks < 4; ++ks) xfrag[ks] = as_bf8(*(const u32x4*)(xb + (mi * 16 + fr) * 136 + ks * 32 + g * 8));
          const int i = mi * 16 + fr; const float ci = cum[i], bi = sbeta[i];
          for (int nj = 0; nj < 4; ++nj) {
              f32x4 acc = {0.f, 0.f, 0.f, 0.f};
              if (nj <= mi) {
#pragma unroll
                  for (int ks = 0; ks < 4; ++ks) { const bf16x8 kfrag = as_bf8(*(const u32x4*)(kb + (nj * 16 + fr) * 136 + ks * 32 + g * 8)); acc = MFMA16(kfrag, xfrag[ks], acc); } }
              float o[4];
#pragma unroll
              for (int r = 0; r < 4; ++r) { const int j = nj * 16 + g * 4 + r; const float dec = __expf(fminf(ci - cum[j], 0.f));
                  if (mat == 0) o[r] = (i > j) ? bi * acc[r] * dec : 0.f; else o[r] = (i >= j) ? scale * acc[r] * dec : 0.f; }
              if (mat == 0) *(float4*)(Af + i * 64 + nj * 16 + g * 4) = make_float4(o[0], o[1], o[2], o[3]);
              else { u32x2 w; w.x = cvt_pk_bf16(o[0], o[1]); w.y = cvt_pk_bf16(o[2], o[3]); *(u32x2*)(QKB(p) + ((size_t)cid * 64 + i) * 64 + nj * 16 + g * 4) = w; }
          } }
        __syncthreads();
        { const float cl = cum[63];
#pragma unroll
          for (int rep = 0; rep < 2; ++rep) { const int task = tid + rep * 512; const int dk = task & 127, tg = task >> 7; float f[8];
#pragma unroll
              for (int j = 0; j < 8; ++j) f[j] = kf[(tg * 8 + j) * 128 + dk] * __expf(cl - cum[tg * 8 + j]);
              *(u32x4*)(KDT(p) + ((size_t)cid * 128 + dk) * 64 + tg * 8) = pack8(f); }
          if (tid == 256) GLAST(p)[cid * 32] = __expf(cl); }
        __syncthreads();
        if (tid < 256) {
            const int c = tid; const bool isu = c < 128; float* col = isu ? (vf + c) : (kf + (c - 128)); const float* fc = isu ? sbeta : fac;
            bf16_t* dst = (isu ? UB(p) : WB(p)) + (size_t)cid * 64 * 128 + (isu ? c : c - 128);
#pragma unroll 1
            for (int bi = 0; bi < 4; ++bi) {
                float r[16];
#pragma unroll
                for (int ii = 0; ii < 16; ++ii) r[ii] = col[(bi * 16 + ii) * 128] * fc[bi * 16 + ii];
#pragma unroll 1
                for (int j0 = 0; j0 < bi * 16; j0 += 4) {
                    const float s0 = col[j0 * 128], s1 = col[(j0 + 1) * 128], s2 = col[(j0 + 2) * 128], s3 = col[(j0 + 3) * 128];
#pragma unroll
                    for (int ii = 0; ii < 16; ++ii) { const float4 av = *(const float4*)(Af + (bi * 16 + ii) * 64 + j0); r[ii] -= av.x * s0 + av.y * s1 + av.z * s2 + av.w * s3; }
                }
#pragma unroll
                for (int ii = 1; ii < 16; ++ii) {
#pragma unroll
                    for (int jj = 0; jj < ii; ++jj) r[ii] -= Af[(bi * 16 + ii) * 64 + bi * 16 + jj] * r[jj]; }
#pragma unroll
                for (int ii = 0; ii < 16; ++ii) { col[(bi * 16 + ii) * 128] = r[ii]; dst[(bi * 16 + ii) * 128] = (bf16_t)(cvt_pk_bf16(r[ii], 0.f) & 0xffffu); }
            }
        }
        __syncthreads();
    }
}

__device__ void p2_moba_prep(const Params& p, unsigned char* lds) {
    bf16_t* vt = (bf16_t*)lds; float* part = (float*)(lds + 69632);
    const int tid = threadIdx.x, slot = tid >> 4, j = tid & 15;
    float qw[8], kw[8], invf[8];
#pragma unroll
    for (int e = 0; e < 8; ++e) { qw[e] = p.qn_w[8 * j + e]; kw[e] = p.kn_w[8 * j + e]; const int i = 8 * (j & 7) + e; invf[e] = exp2f(-(float)(2 * i) * (13.287712379549449f / 128.0f)); }
    for (int it = blockIdx.x; it < 512; it += gridDim.x) {
        const int h = it & 7, blk = (it >> 3) & 15, b = it >> 7; const int tbase = b * SEQ + blk * 256;
        float ks[8];
#pragma unroll
        for (int e = 0; e < 8; ++e) ks[e] = 0.f;
        for (int pass = 0; pass < 8; ++pass) {
            const int tokl = pass * 32 + slot; const size_t off = (size_t)(tbase + tokl) * 1024 + h * 128 + 8 * j; const float pos = (float)(blk * 256 + tokl);
            float cs[8], sn[8];
#pragma unroll
            for (int e = 0; e < 8; ++e) sincosf(pos * invf[e], &sn[e], &cs[e]);
#pragma unroll
            for (int s = 0; s < 2; ++s) { bf16_t* ptr = P_sec(p, 4 + s) + off; float f[8]; unpack8(*(const u32x4*)ptr, f); float ss = 0.f;
#pragma unroll
                for (int e = 0; e < 8; ++e) ss += f[e] * f[e];
                ss += __shfl_xor(ss, 1, 64); ss += __shfl_xor(ss, 2, 64); ss += __shfl_xor(ss, 4, 64); ss += __shfl_xor(ss, 8, 64);
                const float rstd = rsqrtf(ss * (1.0f / 128.0f) + EPSF); float o[8];
#pragma unroll
                for (int e = 0; e < 8; ++e) { const float y = f[e] * rstd * (s ? kw[e] : qw[e]); const float pr = __shfl_xor(y, 8, 64);
                    o[e] = (j < 8) ? (y * cs[e] - pr * sn[e]) : (y * cs[e] + pr * sn[e]); if (s) ks[e] += o[e]; }
                *(u32x4*)ptr = pack8(o); }
            *(u32x4*)(vt + tokl * 136 + 8 * j) = *(const u32x4*)(P_sec(p, 6) + off);
        }
#pragma unroll
        for (int e = 0; e < 8; ++e) part[slot * 128 + 8 * j + e] = ks[e];
        __syncthreads();
        if (tid < 128) { float s = 0.f;
#pragma unroll
            for (int q = 0; q < 32; ++q) s += part[q * 128 + tid];
            KMEAN(p)[(((size_t)b * 8 + h) * 16 + blk) * 128 + tid] = s * (1.0f / 256.0f); }
#pragma unroll
        for (int rep = 0; rep < 8; ++rep) { const int task = tid + rep * 512; const int dv = task & 127, tg = task >> 7; u32x4 w;
            unsigned short e0 = vt[(tg * 8 + 0) * 136 + dv], e1 = vt[(tg * 8 + 1) * 136 + dv], e2 = vt[(tg * 8 + 2) * 136 + dv], e3 = vt[(tg * 8 + 3) * 136 + dv];
            unsigned short e4 = vt[(tg * 8 + 4) * 136 + dv], e5 = vt[(tg * 8 + 5) * 136 + dv], e6 = vt[(tg * 8 + 6) * 136 + dv], e7 = vt[(tg * 8 + 7) * 136 + dv];
            w.x = e0 | ((unsigned)e1 << 16); w.y = e2 | ((unsigned)e3 << 16); w.z = e4 | ((unsigned)e5 << 16); w.w = e6 | ((unsigned)e7 << 16);
            *(u32x4*)(VT(p) + (((size_t)b * 8 + h) * 128 + dv) * SEQ + blk * 256 + tg * 8) = w; }
        __syncthreads();
    }
}

__device__ void p3_gdn_scan(const Params& p, unsigned char* lds) {
    bf16_t* w_s = (bf16_t*)lds; bf16_t* qd_s = (bf16_t*)(lds + 17408); bf16_t* kdT_s = (bf16_t*)(lds + 34816); bf16_t* qk_s = (bf16_t*)(lds + 53248);
    bf16_t* u_s = (bf16_t*)(lds + 62464); bf16_t* ST_s = (bf16_t*)(lds + 64512); bf16_t* vT_s = (bf16_t*)(lds + 68864);
    const int tid = threadIdx.x, wid = tid >> 6, lane = tid & 63, fr = lane & 15, g = lane >> 4;
    for (int item = blockIdx.x; item < 256; item += gridDim.x) {
        const int bh = item >> 3, sl = item & 7, b = bh >> 3, h = bh & 7;
        f32x4 Sacc = {0.f, 0.f, 0.f, 0.f};
        { u32x2 z; z.x = 0u; z.y = 0u; *(u32x2*)(ST_s + fr * 136 + wid * 16 + g * 4) = z; }
        u32x4 rw[2], rq[2], rk[2], rqk, ru;
#define GLOAD(cid_) do { const int _cid = (cid_); _Pragma("unroll") for (int i = 0; i < 2; ++i) { const int e = tid + i * 512; rw[i] = *(const u32x4*)(WB(p) + (size_t)_cid * 8192 + e * 8); rq[i] = *(const u32x4*)(QDB(p) + (size_t)_cid * 8192 + e * 8); rk[i] = *(const u32x4*)(KDT(p) + (size_t)_cid * 8192 + e * 8); } \
            rqk = *(const u32x4*)(QKB(p) + (size_t)_cid * 4096 + tid * 8); \
            if (tid < 128) ru = *(const u32x4*)(UB(p) + (size_t)_cid * 8192 + (tid >> 1) * 128 + sl * 16 + (tid & 1) * 8); } while (0)
        ru = (u32x4){0u, 0u, 0u, 0u};
        GLOAD(bh * 64);
        for (int n = 0; n < 64; ++n) {
            const int cid = bh * 64 + n;
#pragma unroll
            for (int i = 0; i < 2; ++i) { const int e = tid + i * 512; const int r = e >> 4, c = (e & 15) * 8; *(u32x4*)(w_s + r * 136 + c) = rw[i]; *(u32x4*)(qd_s + r * 136 + c) = rq[i];
                const int r2 = e >> 3, c2 = (e & 7) * 8; *(u32x4*)(kdT_s + r2 * 72 + c2) = rk[i]; }
            { const int r = tid >> 3, c = (tid & 7) * 8; *(u32x4*)(qk_s + r * 72 + c) = rqk; }
            if (tid < 128) *(u32x4*)(u_s + (tid >> 1) * 16 + (tid & 1) * 8) = ru;
            const float gl = GLAST(p)[cid * 32];
            __syncthreads();
            if (n + 1 < 64) GLOAD(cid + 1);
            const int mt = wid & 3;
            f32x4 acc = {0.f, 0.f, 0.f, 0.f};
            { const bf16_t* as = (wid < 4 ? w_s : qd_s) + (mt * 16 + fr) * 136 + g * 8; const bf16_t* bs = ST_s + fr * 136 + g * 8;
#pragma unroll
              for (int ks = 0; ks < 4; ++ks) acc = MFMA16(as_bf8(*(const u32x4*)(as + ks * 32)), as_bf8(*(const u32x4*)(bs + ks * 32)), acc); }
            if (wid < 4) { float vn[4];
#pragma unroll
                for (int r = 0; r < 4; ++r) vn[r] = bf2f(u_s[(mt * 16 + g * 4 + r) * 16 + fr]) - acc[r];
                u32x2 w; w.x = cvt_pk_bf16(vn[0], vn[1]); w.y = cvt_pk_bf16(vn[2], vn[3]); *(u32x2*)(vT_s + fr * 72 + mt * 16 + g * 4) = w; }
            __syncthreads();
            bf16x8 vfrag[2];
#pragma unroll
            for (int ks = 0; ks < 2; ++ks) vfrag[ks] = as_bf8(*(const u32x4*)(vT_s + fr * 72 + ks * 32 + g * 8));
            if (wid >= 4) {
#pragma unroll
                for (int ks = 0; ks < 2; ++ks) acc = MFMA16(as_bf8(*(const u32x4*)(qk_s + (mt * 16 + fr) * 72 + ks * 32 + g * 8)), vfrag[ks], acc);
                float* op = OGDN(p) + ((size_t)item * SEQ + n * 64 + mt * 16 + g * 4) * 16 + fr;
#pragma unroll
                for (int r = 0; r < 4; ++r) op[r * 16] = acc[r];
            }
            Sacc *= gl;
#pragma unroll
            for (int ks = 0; ks < 2; ++ks) Sacc = MFMA16(as_bf8(*(const u32x4*)(kdT_s + (wid * 16 + fr) * 72 + ks * 32 + g * 8)), vfrag[ks], Sacc);
            { u32x2 w; w.x = cvt_pk_bf16(Sacc[0], Sacc[1]); w.y = cvt_pk_bf16(Sacc[2], Sacc[3]); *(u32x2*)(ST_s + fr * 136 + wid * 16 + g * 4) = w; }
            __syncthreads();
        }
    }
}

__device__ void p3_moba_attn(const Params& p) {
    const int wid = threadIdx.x >> 6, lane = threadIdx.x & 63, fr = lane & 15, g = lane >> 4;
    const int gw = blockIdx.x * 8 + wid, nw = gridDim.x * 8;
    const float scale = 0.08838834764831845f;
    const bf16_t* MQ = P_sec(p, 4); const bf16_t* MK = P_sec(p, 5); const bf16_t* MZ = P_sec(p, 7);
    for (int it = gw; it < 4096; it += nw) {
        const int rr = it >> 5, bh = it & 31; const int qt = rr < 64 ? 127 - rr : rr - 64; const int b = bh >> 3, h = bh & 7;
        const int q0 = qt * 32, blk = q0 >> 8, qoff = q0 & 255; const size_t tb = (size_t)b * SEQ;
        bf16x8 qf[2][4];
#pragma unroll
        for (int t = 0; t < 2; ++t)
#pragma unroll
            for (int ks = 0; ks < 4; ++ks) qf[t][ks] = as_bf8(*(const u32x4*)(MQ + (tb + q0 + t * 16 + fr) * 1024 + h * 128 + ks * 32 + g * 8));
        unsigned mymask = (1u << blk) - 1u;
        if (blk > 3) {
            const int qi = lane & 31, half = lane >> 5; float gt[8];
#pragma unroll
            for (int i = 0; i < 8; ++i) gt[i] = 0.f;
            const bf16_t* qp = MQ + (tb + q0 + qi) * 1024 + h * 128; const float* km = KMEAN(p) + ((size_t)bh * 16) * 128;
            for (int d0 = 0; d0 < 128; d0 += 8) { float qv[8]; unpack8(*(const u32x4*)(qp + d0), qv);
#pragma unroll
                for (int i = 0; i < 8; ++i) { const int jb = half + 2 * i; if (jb < blk) { const float* kp = km + jb * 128 + d0;
#pragma unroll
                        for (int e = 0; e < 8; ++e) gt[i] += qv[e] * kp[e]; } } }
            float ga[16];
#pragma unroll
            for (int i = 0; i < 8; ++i) { const float o = __shfl_xor(gt[i], 32, 64); ga[2 * i] = half ? o : gt[i]; ga[2 * i + 1] = half ? gt[i] : o; }
            unsigned m = 0u;
#pragma unroll
            for (int s = 0; s < 3; ++s) { float best = -INFINITY; int bi = -1;
#pragma unroll
                for (int jb = 0; jb < 16; ++jb) { const bool ok = (jb < blk) && !((m >> jb) & 1u); if (ok && (ga[jb] > best || bi < 0)) { best = ga[jb]; bi = jb; } }
                if (bi >= 0) m |= 1u << bi; }
            mymask = m;
        }
        unsigned um = mymask;
#pragma unroll
        for (int d = 16; d >= 1; d >>= 1) um |= __shfl_xor(um, d, 64);
        unsigned qmask[2]; qmask[0] = __shfl(mymask, fr, 64); qmask[1] = __shfl(mymask, 16 + fr, 64);
        f32x4 O[2][8];
#pragma unroll
        for (int t = 0; t < 2; ++t)
#pragma unroll
            for (int d = 0; d < 8; ++d) O[t][d] = (f32x4){0.f, 0.f, 0.f, 0.f};
        float mrun[2] = {-INFINITY, -INFINITY}, lrun[2] = {0.f, 0.f};
        const bf16_t* vtb = VT(p) + ((size_t)bh * 128) * SEQ;
        for (int jb = 0; jb <= blk; ++jb) {
            const bool own = (jb == blk);
            if (!own && !((um >> jb) & 1u)) continue;
            const int nkc = own ? (qoff >> 5) + 1 : 8;
            for (int kc = 0; kc < nkc; ++kc) {
                const int kbase = jb * 256 + kc * 32;
                f32x4 st[2][2];
#pragma unroll
                for (int t = 0; t < 2; ++t)
#pragma unroll
                    for (int kt = 0; kt < 2; ++kt) st[t][kt] = (f32x4){0.f, 0.f, 0.f, 0.f};
#pragma unroll
                for (int kt = 0; kt < 2; ++kt) { const bf16_t* kp = MK + (tb + kbase + kt * 16 + fr) * 1024 + h * 128 + g * 8;
#pragma unroll
                    for (int ks = 0; ks < 4; ++ks) { const bf16x8 kfr = as_bf8(*(const u32x4*)(kp + ks * 32));
                        st[0][kt] = MFMA16(kfr, qf[0][ks], st[0][kt]); st[1][kt] = MFMA16(kfr, qf[1][ks], st[1][kt]); } }
                bf16x8 pf[2];
#pragma unroll
                for (int t = 0; t < 2; ++t) {
                    const bool sel = own || ((qmask[t] >> jb) & 1u);
                    float s[8]; float mx = -INFINITY;
#pragma unroll
                    for (int kt = 0; kt < 2; ++kt)
#pragma unroll
                        for (int r = 0; r < 4; ++r) { bool ok = sel; if (own) ok = (kc * 32 + kt * 16 + g * 4 + r) <= (qoff + t * 16 + fr);
                            const float v = ok ? st[t][kt][r] * scale : -INFINITY; s[kt * 4 + r] = v; mx = fmaxf(mx, v); }
                    mx = fmaxf(mx, __shfl_xor(mx, 16, 64)); mx = fmaxf(mx, __shfl_xor(mx, 32, 64));
                    const float mnew = fmaxf(mrun[t], mx); const float msafe = (mnew == -INFINITY) ? 0.f : mnew;
                    const float alpha = __expf(mrun[t] - msafe); mrun[t] = mnew;
                    float ps = 0.f; float pv[8];
#pragma unroll
                    for (int e = 0; e < 8; ++e) { pv[e] = __expf(s[e] - msafe); ps += pv[e]; }
                    lrun[t] = lrun[t] * alpha + ps;
#pragma unroll
                    for (int d = 0; d < 8; ++d) O[t][d] *= alpha;
                    pf[t] = as_bf8(pack8(pv));
                }
#pragma unroll
                for (int d = 0; d < 8; ++d) { const bf16_t* vp = vtb + (size_t)(d * 16 + fr) * SEQ + kbase + g * 4;
                    const u32x2 v0 = *(const u32x2*)vp, v1 = *(const u32x2*)(vp + 16); u32x4 vv; vv.x = v0.x; vv.y = v0.y; vv.z = v1.x; vv.w = v1.y; const bf16x8 vfr = as_bf8(vv);
                    O[0][d] = MFMA16(vfr, pf[0], O[0][d]); O[1][d] = MFMA16(vfr, pf[1], O[1][d]); }
            }
        }
#pragma unroll
        for (int t = 0; t < 2; ++t) { float l = lrun[t]; l += __shfl_xor(l, 16, 64); l += __shfl_xor(l, 32, 64); const float inv = 1.0f / l;
            const size_t ro = (tb + q0 + t * 16 + fr) * 1024 + h * 128 + g * 4;
#pragma unroll
            for (int d = 0; d < 8; ++d) { const u32x2 zz = *(const u32x2*)(MZ + ro + d * 16); const float z0 = bflo(zz.x), z1 = bfhi(zz.x), z2 = bflo(zz.y), z3 = bfhi(zz.y);
                u32x2 w; w.x = cvt_pk_bf16(O[t][d][0] * inv * siluf_(z0), O[t][d][1] * inv * siluf_(z1)); w.y = cvt_pk_bf16(O[t][d][2] * inv * siluf_(z2), O[t][d][3] * inv * siluf_(z3));
                *(u32x2*)(OB(p) + ro + d * 16) = w; } }
    }
}

__device__ void p4_gdn_post(const Params& p) {
    const int j = threadIdx.x & 15; const bf16_t* GZ = P_sec(p, 3);
    float nw[8];
#pragma unroll
    for (int e = 0; e < 8; ++e) nw[e] = p.gdn_norm_w[8 * j + e];
    for (int pr = blockIdx.x * 32 + (threadIdx.x >> 4); pr < NTOK * 8; pr += gridDim.x * 32) {
        const size_t off = (size_t)pr * 128 + 8 * j;
        const int tok = pr >> 3, hh = pr & 7; const size_t goff = ((((size_t)(tok >> 12) * 8 + hh) * 8 + (j >> 1)) * SEQ + (tok & 4095)) * 16 + (j & 1) * 8;
        const float4 a = *(const float4*)(OGDN(p) + goff), c = *(const float4*)(OGDN(p) + goff + 4);
        float f[8] = {a.x, a.y, a.z, a.w, c.x, c.y, c.z, c.w}; float ss = 0.f;
#pragma unroll
        for (int e = 0; e < 8; ++e) ss += f[e] * f[e];
        ss += __shfl_xor(ss, 1, 64); ss += __shfl_xor(ss, 2, 64); ss += __shfl_xor(ss, 4, 64); ss += __shfl_xor(ss, 8, 64);
        const float rstd = rsqrtf(ss * (1.0f / 128.0f) + EPSF); float z[8]; unpack8(*(const u32x4*)(GZ + off), z); float o[8];
#pragma unroll
        for (int e = 0; e < 8; ++e) o[e] = f[e] * rstd * nw[e] * siluf_(z[e]);
        *(u32x4*)(OA(p) + off) = pack8(o);
    }
}

__device__ __forceinline__ unsigned* BARCTR(const Params& p) { return (unsigned*)(p.ws + 482 * MIB); }
__device__ __forceinline__ void grid_barrier(unsigned* ctr, unsigned& target) {
    __builtin_amdgcn_fence(__ATOMIC_RELEASE, "agent");
    asm volatile("s_waitcnt vmcnt(0) lgkmcnt(0)" ::: "memory");
    __syncthreads();
    target += gridDim.x;
    if (threadIdx.x == 0) {
        __hip_atomic_fetch_add(ctr, 1u, __ATOMIC_RELAXED, __HIP_MEMORY_SCOPE_AGENT);
        while (__hip_atomic_load(ctr, __ATOMIC_RELAXED, __HIP_MEMORY_SCOPE_AGENT) < target) __builtin_amdgcn_s_sleep(2);
    }
    __syncthreads();
    __builtin_amdgcn_fence(__ATOMIC_ACQUIRE, "agent");
    asm volatile("s_waitcnt vmcnt(0)" ::: "memory");
}

__device__ void dbg_dump(const Params& p, const bf16_t* a, const bf16_t* b) {
    for (size_t i = (size_t)blockIdx.x * 512 + threadIdx.x; i < (size_t)NTOK * 256; i += (size_t)gridDim.x * 512) {
        const size_t r = i >> 8; const int c8 = (int)(i & 255) * 8; const bf16_t* src = (c8 < 1024 ? a : b) + r * 1024 + (c8 & 1023);
        float f[8]; unpack8(*(const u32x4*)src, f);
        *(float4*)(p.out + r * 2048 + c8) = make_float4(f[0], f[1], f[2], f[3]); *(float4*)(p.out + r * 2048 + c8 + 4) = make_float4(f[4], f[5], f[6], f[7]); }
}

__global__ void __launch_bounds__(512, 2) fwd_megakernel(Params p) {
    extern __shared__ __attribute__((aligned(16))) unsigned char shm[];
    cg::grid_group grid = cg::this_grid();
    grid.sync();
    unsigned* bctr = BARCTR(p); unsigned btarget = 0u;
    PG8_LAS unsigned char* lds = (PG8_LAS unsigned char*)shm;
    const int G = (int)gridDim.x, c = (int)blockIdx.x;
#ifndef PHM
#define PHM 0xff
#endif
    if (PHM & 1) { p0_rows(p);
    p0_transposes(p, (float*)shm); }
    grid_barrier(bctr, btarget);
    if (PHM & 2) { p1_skinny(p, (float*)shm);
    { pg8::StaticOrder S; S.init(NTOK, 12288, G, c); pg8::Gemm gm{HB(p), WinT(p), NTOK, 12288, 2048}; Epi1 E{(bf16_t*)p.ws};
      pg8::gemm_phase<Epi1, pg8::StaticOrder, false>(lds, gm, S, E, nullptr); } }
    grid_barrier(bctr, btarget);
    if (PHM & 4) p2_gdn_prep(p, shm);
    if (PHM & 8) p2_moba_prep(p, shm);
    grid_barrier(bctr, btarget);
#if DBG == 2
    dbg_dump(p, P_sec(p, 4), P_sec(p, 5)); return;
#elif DBG == 3
    dbg_dump(p, P_sec(p, 0), P_sec(p, 3)); return;
#elif DBG == 4 || DBG == 5
    { const u32x4* s0 = (const u32x4*)(DBG == 4 ? UB(p) : QDB(p)); const u32x4* s1 = (const u32x4*)(DBG == 4 ? WB(p) : KDT(p)); u32x4* d0 = (u32x4*)OB(p); u32x4* d1 = (u32x4*)VT(p);
      for (size_t i = (size_t)blockIdx.x * 512 + threadIdx.x; i < (size_t)2097152; i += (size_t)gridDim.x * 512) { d0[i] = s0[i]; d1[i] = s1[i]; }
      grid_barrier(bctr, btarget); dbg_dump(p, OB(p), VT(p)); return; }
#endif
    if (PHM & 16) p3_gdn_scan(p, shm);
    if (PHM & 32) p3_moba_attn(p);
    grid_barrier(bctr, btarget);
    if (PHM & 64) p4_gdn_post(p);
    grid_barrier(bctr, btarget);
#if DBG == 1
    dbg_dump(p, OA(p), OB(p)); return;
#elif DBG == 7
    dbg_dump(p, OA(p), OA(p)); return;
#elif DBG == 8
    dbg_dump(p, OB(p), OB(p)); return;
#endif
    if (PHM & 128) { pg8::StaticOrder S; S.init(NTOK, 2048, G, c);
      { pg8::Gemm gm{OA(p), WgT(p), NTOK, 2048, 1024}; Epi2<0> E{MERGED(p), P_sec(p, 8)}; pg8::gemm_phase<Epi2<0>, pg8::StaticOrder, false>(lds, gm, S, E, nullptr); }
      { pg8::Gemm gm{OB(p), WmT(p), NTOK, 2048, 1024}; Epi2<1> E{MERGED(p), P_sec(p, 10)}; pg8::gemm_phase<Epi2<1>, pg8::StaticOrder, false>(lds, gm, S, E, nullptr); } }
    grid_barrier(bctr, btarget);
    if (PHM & 128) { pg8::StaticOrder S; S.init(NTOK, 2048, G, c); pg8::Gemm gm{MERGED(p), WoT(p), NTOK, 2048, 2048}; Epi3 E{p.out, p.x};
      pg8::gemm_phase<Epi3, pg8::StaticOrder, false>(lds, gm, S, E, nullptr); }
}

extern "C" void kernel_launch(void* const* d_in, const int* in_sizes, int n_in, void* d_out, int out_size, void* d_ws, size_t ws_size, hipStream_t stream) {
    constexpr size_t kDynLds = 131072;
    static int grid_blocks = 0;
    if (!grid_blocks) {
        int dev = 0, cus = 0, per_cu = 0;
        hipGetDevice(&dev);
        hipDeviceGetAttribute(&cus, hipDeviceAttributeMultiprocessorCount, dev);
        hipFuncSetAttribute((const void*)fwd_megakernel, hipFuncAttributeMaxDynamicSharedMemorySize, (int)kDynLds);
        hipOccupancyMaxActiveBlocksPerMultiprocessor(&per_cu, fwd_megakernel, 512, kDynLds);
        if (per_cu < 1) per_cu = 1;
        grid_blocks = cus * per_cu;
        if (grid_blocks > 256) grid_blocks = 256;
    }
    Params p{};
    p.x = (const float*)d_in[0]; p.norm_w = (const float*)d_in[1]; p.w_in = (const float*)d_in[2]; p.conv_w = (const float*)d_in[3];
    p.a_log = (const float*)d_in[4]; p.dt_bias = (const float*)d_in[5]; p.gdn_norm_w = (const float*)d_in[6]; p.qn_w = (const float*)d_in[7]; p.kn_w = (const float*)d_in[8];
    p.w_out_gdn = (const float*)d_in[9]; p.w_out_moba = (const float*)d_in[10]; p.w_o = (const float*)d_in[11];
    p.out = (float*)d_out; p.ws = (unsigned char*)d_ws;
    hipMemsetAsync((unsigned char*)d_ws + (size_t)482 * 1048576, 0, 256, stream);
    void* args[] = {&p};
    hipError_t e = hipLaunchCooperativeKernel((void*)fwd_megakernel, dim3(grid_blocks), dim3(512), args, kDynLds, stream);
    if (e != hipSuccess) fprintf(stderr, "cooperative launch failed: %s (grid %d)\n", hipGetErrorString(e), grid_blocks);
}
```

```cpp
#include <hip/hip_runtime.h>
#include <hip/hip_cooperative_groups.h>
#include <cstdio>
#define SCAN_NT 4
namespace cg = cooperative_groups;
namespace pg8 {
#define PG8_LAS __attribute__((address_space(3)))
typedef unsigned short bf16_t;
typedef short bf16x8 __attribute__((ext_vector_type(8)));
typedef float f32x4 __attribute__((ext_vector_type(4)));
typedef unsigned u32x4 __attribute__((ext_vector_type(4)));
constexpr int BM = 256, BK = 64, HALF = 128, HTB = HALF * BK * 2  , STAGE_BYTES = 8 * HTB, NXCD = 8, WGM = 8;

__host__ __device__ __forceinline__ int lds_byte(int r, int c) { const int st = (r >> 4) * 2 + (c >> 5), rr = r & 15, cc = c & 31, ob = rr * 64 + cc * 2; return st * 1024 + (ob ^ (((ob >> 9) & 1) << 5)); }
__host__ __device__ __forceinline__ void stage_rc(int b, int& R, int& C) { const int st = b / 1024, sb = b % 1024, swz = sb ^ (((sb >> 9) & 1) << 5); R = (st >> 1) * 16 + swz / 64; C = (st & 1) * 32 + (swz % 64) / 2; }
__host__ __device__ __forceinline__ int perm32(int rho) { const int n = rho >> 4, i = rho & 15; return 8 * (i >> 2) + 4 * n + (i & 3); }

struct Unit { int pm, pn, pass; };
struct Gemm { const bf16_t* A; const bf16_t* Bt; int M, N, K; const bf16_t* A2; const bf16_t* Bt2; };

struct StaticOrder {
    int nM, nN, nwg, G, c;
    __host__ __device__ void init(int M, int N, int G_, int c_) { nM = M / BM; nN = N / BM; nwg = nM * nN; G = G_; c = c_; }
    __host__ __device__ bool next(int i, Unit& u) const {
        const long L = (long)i * G + c; if (L >= nwg) return false;
        int wgid = (int)L; { const int q = nwg / NXCD, r = nwg % NXCD, xcd = wgid % NXCD, off = wgid / NXCD; wgid = (xcd < r ? xcd * (q + 1) : r * (q + 1) + (xcd - r) * q) + off; }
        const int nig = WGM * nN, gid = wgid / nig, fm = gid * WGM, gsz = (nM - fm) < WGM ? (nM - fm) : WGM;
        u.pm = fm + ((wgid % nig) % gsz); u.pn = (wgid % nig) / gsz; u.pass = 0; return true;
    }
    __device__ __forceinline__ void a_ready(const Unit&) const {}
    __device__ __forceinline__ void done(const Unit&) const {}
};
typedef __bf16 bf16v2_t __attribute__((ext_vector_type(2)));
__device__ __forceinline__ unsigned cvt_pk_bf16(float lo, float hi) { bf16v2_t v; v.x = (__bf16)lo; v.y = (__bf16)hi; return __builtin_bit_cast(unsigned, v); }
template <class Epi, class Sched, bool STAMP = false>
__device__ __forceinline__ void gemm_phase(PG8_LAS unsigned char* lds, const Gemm g, const Sched& S, const Epi& E, unsigned long long* stamps) {
    const int tid = threadIdx.x, wid = __builtin_amdgcn_readfirstlane(tid >> 6), lane = tid & 63, wr = wid >> 2, wc = wid & 3, fr = lane & 15, fq = lane >> 4;
    const int K = g.K, nt = K / BK;
    int ts_lo = 0, ts_hi = 0, nts = 0; const unsigned long long rt_entry = STAMP ? (unsigned long long)wall_clock64() : 0ull;
#define PG8_STAMP() do { if (STAMP && wid == 0 && nts < 64) { const unsigned long long _c = (unsigned long long)clock64(); \
        ts_lo = (lane == nts) ? (int)(unsigned)_c : ts_lo; ts_hi = (lane == nts) ? (int)(unsigned)(_c >> 32) : ts_hi; ++nts; } } while (0)
    PG8_STAMP();
    unsigned voffA[2], voffB[2];
#pragma unroll
    for (int i = 0; i < 2; ++i) { int R, C; stage_rc(tid * 16 + i * 8192, R, C); const int Rb = Epi::PERM ? ((R & ~31) + perm32(R & 31)) : R;
        voffA[i] = (unsigned)(R * K + C) * 2u; voffB[i] = (unsigned)(Rb * K + C) * 2u; }
    const size_t kstep = (size_t)(BK * 2);
    const size_t hstep = (size_t)HALF * K * 2;
    const size_t tstep = 2 * hstep;
    const unsigned ldsw = (unsigned)wid * 1024u;
    const int aoff = lds_byte(wr * 64 + fr, fq * 8), boff = lds_byte(wc * 32 + fr, fq * 8);
#define PG8_SA(b, h) (((b) * 2 + (h)) * HTB)
#define PG8_SB(b, h) ((4 + (b) * 2 + (h)) * HTB)
#define PG8_STAGE(bufoff, gbase, voff) do { _Pragma("unroll") for (int _i = 0; _i < 2; ++_i) \
        __builtin_amdgcn_global_load_lds((const unsigned*)((const char*)(gbase) + (voff)[_i]), (PG8_LAS unsigned*)(lds + (bufoff) + ldsw + _i * 8192), 16, 0, 0); } while (0)
#define PG8_LDA(dst, b, h) do { _Pragma("unroll") for (int m = 0; m < 4; ++m) _Pragma("unroll") for (int k = 0; k < 2; ++k) dst[m][k] = *(const PG8_LAS bf16x8*)(lds + PG8_SA(b, h) + aoff + m * 2048 + k * 1024); } while (0)
#define PG8_LDB(dst, b, h) do { _Pragma("unroll") for (int n = 0; n < 2; ++n) _Pragma("unroll") for (int k = 0; k < 2; ++k) dst[n][k] = *(const PG8_LAS bf16x8*)(lds + PG8_SB(b, h) + boff + n * 2048 + k * 1024); } while (0)
#define PG8_MMA(ai, bj, At, Bt) do { __builtin_amdgcn_s_setprio(1); _Pragma("unroll") for (int m = 0; m < 4; ++m) _Pragma("unroll") for (int n = 0; n < 2; ++n) _Pragma("unroll") for (int k = 0; k < 2; ++k) \
        acc[ai][bj][m][n] = __builtin_amdgcn_mfma_f32_16x16x32_bf16(Bt[n][k], At[m][k], acc[ai][bj][m][n], 0, 0, 0); __builtin_amdgcn_s_setprio(0); } while (0)
#define PG8_WAIT_V(n) asm volatile("s_waitcnt vmcnt(" #n ")" ::: "memory")
#define PG8_WAIT_L(n) asm volatile("s_waitcnt lgkmcnt(" #n ")" ::: "memory")
#define PG8_BAR __builtin_amdgcn_s_barrier()
#define PG8_SCHED __builtin_amdgcn_sched_barrier(0)
    Unit cur, nxt; int ui = 0;
    if (!S.next(0, cur)) return;
    f32x4 acc[2][2][4][2];
#pragma unroll
    for (int a = 0; a < 2; ++a)
#pragma unroll
        for (int b = 0; b < 2; ++b)
#pragma unroll
            for (int m = 0; m < 4; ++m)
#pragma unroll
                for (int n = 0; n < 2; ++n) acc[a][b][m][n] = (f32x4){0.f, 0.f, 0.f, 0.f};
    bf16x8 At[4][2], B0[2][2], B1[2][2];
    const char* cA = (const char*)(cur.pass ? g.A2 : g.A) + (size_t)cur.pm * tstep; const char* cB = (const char*)(cur.pass ? g.Bt2 : g.Bt) + (size_t)cur.pn * tstep;
    S.a_ready(cur);
    PG8_STAGE(PG8_SB(0, 0), cB, voffB); PG8_STAGE(PG8_SA(0, 0), cA, voffA); PG8_STAGE(PG8_SB(0, 1), cB + hstep, voffB); PG8_STAGE(PG8_SA(0, 1), cA + hstep, voffA);
    if (wr == 1) PG8_BAR;
    PG8_WAIT_V(4); PG8_BAR;
    PG8_STAGE(PG8_SB(1, 0), cB + kstep, voffB); PG8_STAGE(PG8_SA(1, 0), cA + kstep, voffA); PG8_STAGE(PG8_SB(1, 1), cB + hstep + kstep, voffB);
    PG8_WAIT_V(6); PG8_BAR;
    PG8_STAMP();
    for (;;) {
        const bool has_next = S.next(ui + 1, nxt);
        const char* nA = has_next ? (const char*)(nxt.pass ? g.A2 : g.A) + (size_t)nxt.pm * tstep : cA; const char* nB = has_next ? (const char*)(nxt.pass ? g.Bt2 : g.Bt) + (size_t)nxt.pn * tstep : cB;
        for (int t = 0; t < nt; t += 2) {
            const bool last = (t == nt - 2);
            const char* a1 = cA + (size_t)(t + 1) * kstep;
            const char* a2 = last ? nA : cA + (size_t)(t + 2) * kstep; const char* b2 = last ? nB : cB + (size_t)(t + 2) * kstep;
            const char* a3 = a2 + kstep; const char* b3 = b2 + kstep;
            if (last && has_next) S.a_ready(nxt);
            PG8_LDB(B0, 0, 0); PG8_SCHED; PG8_LDA(At, 0, 0); PG8_STAGE(PG8_SA(1, 1), a1 + hstep, voffA);
            PG8_WAIT_L(8); PG8_BAR; PG8_WAIT_L(0); PG8_MMA(0, 0, At, B0); PG8_BAR; PG8_SCHED;
            PG8_LDB(B1, 0, 1); PG8_STAGE(PG8_SB(0, 0), b2, voffB);
            PG8_BAR; PG8_WAIT_L(0); PG8_MMA(0, 1, At, B1); PG8_BAR;
            PG8_LDA(At, 0, 1); PG8_STAGE(PG8_SA(0, 0), a2, voffA);
            PG8_BAR; PG8_WAIT_L(0); PG8_MMA(1, 0, At, B0); PG8_BAR; PG8_SCHED;
            PG8_STAGE(PG8_SB(0, 1), b2 + hstep, voffB);
            PG8_WAIT_V(6); PG8_BAR; PG8_MMA(1, 1, At, B1); PG8_BAR;
            PG8_LDB(B0, 1, 0); PG8_SCHED; PG8_LDA(At, 1, 0); PG8_STAGE(PG8_SA(0, 1), a2 + hstep, voffA);
            PG8_WAIT_L(8); PG8_BAR; PG8_WAIT_L(0); PG8_MMA(0, 0, At, B0); PG8_BAR; PG8_SCHED;
            PG8_LDB(B1, 1, 1); PG8_STAGE(PG8_SB(1, 0), b3, voffB);
            PG8_BAR; PG8_WAIT_L(0); PG8_MMA(0, 1, At, B1); PG8_BAR;
            PG8_LDA(At, 1, 1); PG8_STAGE(PG8_SA(1, 0), a3, voffA);
            PG8_BAR; PG8_WAIT_L(0); PG8_MMA(1, 0, At, B0); PG8_BAR; PG8_SCHED;
            PG8_STAGE(PG8_SB(1, 1), b3 + hstep, voffB);
            PG8_WAIT_V(6); PG8_BAR; PG8_MMA(1, 1, At, B1); PG8_BAR;
        }
        PG8_STAMP();
        if constexpr (!Epi::AFTER_DRAIN) { E(acc, cur, wr, wc, fr, fq); S.done(cur); }
        PG8_STAMP();
        if (!has_next) break;
#pragma unroll
        for (int a = 0; a < 2; ++a)
#pragma unroll
            for (int b = 0; b < 2; ++b)
#pragma unroll
                for (int m = 0; m < 4; ++m)
#pragma unroll
                    for (int n = 0; n < 2; ++n) acc[a][b][m][n] = (f32x4){0.f, 0.f, 0.f, 0.f};
        cur = nxt; cA = nA; cB = nB; ++ui;
    }
    PG8_WAIT_V(0);
    if (wr == 0) PG8_BAR;
    PG8_BAR;
    if constexpr (Epi::AFTER_DRAIN) { E.fused(acc, cur, wr, wc, fr, fq, lds, wid, lane); S.done(cur); }
    PG8_STAMP();
    if (STAMP && wid == 0) { stamps[lane] = lane < nts ? (((unsigned long long)(unsigned)ts_hi << 32) | (unsigned)ts_lo) : 0ull;
        if (lane == 62) stamps[62] = rt_entry; if (lane == 63) stamps[63] = (unsigned long long)wall_clock64(); }
#undef PG8_STAMP
#undef PG8_SA
#undef PG8_SB
#undef PG8_STAGE
#undef PG8_LDA
#undef PG8_LDB
#undef PG8_MMA
#undef PG8_WAIT_V
#undef PG8_WAIT_L
#undef PG8_BAR
#undef PG8_SCHED
}
}
#ifndef DBG
#define DBG 0
#endif
#ifndef SCAN_NT
#define SCAN_NT 2
#endif
#ifndef REP
#define REP 0
#endif
using pg8::bf16_t; using pg8::bf16x8; using pg8::f32x4; using pg8::u32x4; using pg8::cvt_pk_bf16;
typedef unsigned u32x2 __attribute__((ext_vector_type(2)));

constexpr int NTOK = 16384, DM = 2048, SEQ = 4096, NH = 8, HD = 128, INC = 12304;
constexpr float EPSF = 1e-6f;
constexpr size_t MIB = 1048576;
constexpr size_t SEC = (size_t)NTOK * 1024;

struct Params {
    const float *x, *norm_w, *w_in, *conv_w, *a_log, *dt_bias, *gdn_norm_w, *qn_w, *kn_w, *w_out_gdn, *w_out_moba, *w_o;
    float* out; unsigned char* ws;
};

__device__ __forceinline__ bf16_t* P_sec(const Params& p, int s) { return (bf16_t*)p.ws + (size_t)s * SEC; }
__device__ __forceinline__ bf16_t* WgT(const Params& p) { return (bf16_t*)(p.ws + 384 * MIB); }
__device__ __forceinline__ bf16_t* WmT(const Params& p) { return (bf16_t*)(p.ws + 388 * MIB); }
__device__ __forceinline__ bf16_t* WoT(const Params& p) { return (bf16_t*)(p.ws + 392 * MIB); }
__device__ __forceinline__ float* BETA(const Params& p) { return (float*)(p.ws + 400 * MIB); }
__device__ __forceinline__ float* GLOG(const Params& p) { return (float*)(p.ws + 400 * MIB + 524288); }
__device__ __forceinline__ float* KMEAN(const Params& p) { return (float*)(p.ws + 401 * MIB); }
__device__ __forceinline__ float* GLAST(const Params& p) { return (float*)(p.ws + 401 * MIB + 524288); }
__device__ __forceinline__ bf16_t* QKB(const Params& p) { return (bf16_t*)(p.ws + 402 * MIB); }
__device__ __forceinline__ bf16_t* OB(const Params& p) { return (bf16_t*)(p.ws + 418 * MIB); }
__device__ __forceinline__ bf16_t* VT(const Params& p) { return (bf16_t*)(p.ws + 450 * MIB); }
__device__ __forceinline__ unsigned* BARCTR(const Params& p) { return (unsigned*)(p.ws + 482 * MIB); }
__device__ __forceinline__ float2* ROPE(const Params& p) { return (float2*)(p.ws + 484 * MIB); }
__device__ __forceinline__ float* OGDN(const Params& p) { return (float*)p.ws; }
__device__ __forceinline__ bf16_t* OA(const Params& p) { return P_sec(p, 2); }
__device__ __forceinline__ bf16_t* MERGED(const Params& p) { return P_sec(p, 4); }
__device__ __forceinline__ bf16_t* HB(const Params& p) { return (bf16_t*)p.out; }
__device__ __forceinline__ bf16_t* WinT(const Params& p) { return (bf16_t*)((unsigned char*)p.out + 64 * MIB); }
__device__ __forceinline__ bf16_t* UB(const Params& p) { return (bf16_t*)p.out; }
__device__ __forceinline__ bf16_t* WB(const Params& p) { return (bf16_t*)((unsigned char*)p.out + 32 * MIB); }
__device__ __forceinline__ bf16_t* QDB(const Params& p) { return (bf16_t*)((unsigned char*)p.out + 64 * MIB); }
__device__ __forceinline__ bf16_t* KDT(const Params& p) { return (bf16_t*)((unsigned char*)p.out + 96 * MIB); }

__device__ __forceinline__ float bf2f(unsigned short b) { return __uint_as_float(((unsigned)b) << 16); }
__device__ __forceinline__ float bflo(unsigned w) { return __uint_as_float(w << 16); }
__device__ __forceinline__ float bfhi(unsigned w) { return __uint_as_float(w & 0xffff0000u); }
__device__ __forceinline__ bf16x8 as_bf8(u32x4 v) { return __builtin_bit_cast(bf16x8, v); }
__device__ __forceinline__ float sigmoidf_(float v) { return __builtin_amdgcn_rcpf(1.0f + __expf(-v)); }
__device__ __forceinline__ float siluf_(float v) { return v * __builtin_amdgcn_rcpf(1.0f + __expf(-v)); }
__device__ __forceinline__ void unpack8(u32x4 v, float* f) { f[0] = bflo(v.x); f[1] = bfhi(v.x); f[2] = bflo(v.y); f[3] = bfhi(v.y); f[4] = bflo(v.z); f[5] = bfhi(v.z); f[6] = bflo(v.w); f[7] = bfhi(v.w); }
__device__ __forceinline__ u32x4 pack8(const float* f) { u32x4 w; w.x = cvt_pk_bf16(f[0], f[1]); w.y = cvt_pk_bf16(f[2], f[3]); w.z = cvt_pk_bf16(f[4], f[5]); w.w = cvt_pk_bf16(f[6], f[7]); return w; }
#define MFMA16(a, b, c) __builtin_amdgcn_mfma_f32_16x16x32_bf16((a), (b), (c), 0, 0, 0)

struct Epi1 {
    static constexpr bool PERM = true, AFTER_DRAIN = false;
    bf16_t* P;
    __device__ __forceinline__ void operator()(const f32x4 (&acc)[2][2][4][2], const pg8::Unit& u, int wr, int wc, int fr, int fq) const {
        const int row0 = u.pm * 256 + wr * 64 + fr; int colt = u.pn * 256; bf16_t* base = P + (size_t)(colt >> 10) * SEC; colt &= 1023;
        const int col0 = colt + wc * 32 + 8 * fq;
#pragma unroll
        for (int ai = 0; ai < 2; ++ai)
#pragma unroll
            for (int m = 0; m < 4; ++m) { bf16_t* rowp = base + (size_t)(row0 + ai * 128 + m * 16) * 1024 + col0;
#pragma unroll
                for (int bj = 0; bj < 2; ++bj) { const f32x4 v0 = acc[ai][bj][m][0], v1 = acc[ai][bj][m][1];
                    u32x4 w; w.x = cvt_pk_bf16(v0[0], v0[1]); w.y = cvt_pk_bf16(v0[2], v0[3]); w.z = cvt_pk_bf16(v1[0], v1[1]); w.w = cvt_pk_bf16(v1[2], v1[3]);
                    *(u32x4*)(rowp + bj * 128) = w; } }
    }
};
struct Epi2 {
    static constexpr bool PERM = true, AFTER_DRAIN = false;
    bf16_t* M; const bf16_t* G0; const bf16_t* G1;
    __device__ __forceinline__ void operator()(const f32x4 (&acc)[2][2][4][2], const pg8::Unit& u, int wr, int wc, int fr, int fq) const {
        const int row0 = u.pm * 256 + wr * 64 + fr; const int colt = u.pn * 256; const bool second = u.pass != 0;
        const bf16_t* gb = (second ? G1 : G0) + (size_t)(colt >> 10) * SEC + (colt & 1023) + wc * 32 + 8 * fq; bf16_t* mb = M + colt + wc * 32 + 8 * fq;
#pragma unroll
        for (int ai = 0; ai < 2; ++ai) {
            u32x4 gv[4][2], ov[4][2];
#pragma unroll
            for (int m = 0; m < 4; ++m)
#pragma unroll
                for (int bj = 0; bj < 2; ++bj) { const int row = row0 + ai * 128 + m * 16; gv[m][bj] = *(const u32x4*)(gb + (size_t)row * 1024 + bj * 128);
                    ov[m][bj] = second ? *(const u32x4*)(mb + (size_t)row * 2048 + bj * 128) : (u32x4){0u, 0u, 0u, 0u}; }
#pragma unroll
            for (int m = 0; m < 4; ++m)
#pragma unroll
                for (int bj = 0; bj < 2; ++bj) { const int row = row0 + ai * 128 + m * 16; const f32x4 v0 = acc[ai][bj][m][0], v1 = acc[ai][bj][m][1];
                    float g[8], old[8], o[8]; unpack8(gv[m][bj], g); unpack8(ov[m][bj], old);
#pragma unroll
                    for (int e = 0; e < 4; ++e) { o[e] = sigmoidf_(g[e]) * v0[e] + old[e]; o[4 + e] = sigmoidf_(g[4 + e]) * v1[e] + old[4 + e]; }
                    *(u32x4*)(mb + (size_t)row * 2048 + bj * 128) = pack8(o); }
        }
    }
};
struct PairOrder { pg8::StaticOrder base;
    __device__ bool next(int i, pg8::Unit& u) const { if (!base.next(i >> 1, u)) return false; u.pass = i & 1; return true; }
    __device__ __forceinline__ void a_ready(const pg8::Unit&) const {}
    __device__ __forceinline__ void done(const pg8::Unit&) const {}
};
struct Epi3 {
    static constexpr bool PERM = false, AFTER_DRAIN = false;
    float* O; const float* X;
    __device__ __forceinline__ void operator()(const f32x4 (&acc)[2][2][4][2], const pg8::Unit& u, int wr, int wc, int fr, int fq) const {
        const int row0 = u.pm * 256 + wr * 64 + fr, col0 = u.pn * 256 + wc * 32 + 4 * fq;
#pragma unroll
        for (int ai = 0; ai < 2; ++ai) {
            f32x4 xv[4][2][2];
#pragma unroll
            for (int m = 0; m < 4; ++m)
#pragma unroll
                for (int bj = 0; bj < 2; ++bj)
#pragma unroll
                    for (int n = 0; n < 2; ++n) xv[m][bj][n] = *(const f32x4*)(X + (size_t)(row0 + ai * 128 + m * 16) * DM + col0 + bj * 128 + n * 16);
#pragma unroll
            for (int m = 0; m < 4; ++m)
#pragma unroll
                for (int bj = 0; bj < 2; ++bj)
#pragma unroll
                    for (int n = 0; n < 2; ++n) *(f32x4*)(O + (size_t)(row0 + ai * 128 + m * 16) * DM + col0 + bj * 128 + n * 16) = acc[ai][bj][m][n] + xv[m][bj][n];
        }
    }
};

__device__ __forceinline__ float wave_sum(float v) {
#pragma unroll
    for (int d = 32; d >= 1; d >>= 1) v += __shfl_xor(v, d, 64);
    return v;
}
__device__ void p0_rows(const Params& p) {
    const int wid = __builtin_amdgcn_readfirstlane(threadIdx.x >> 6), lane = threadIdx.x & 63;
    bf16_t* H = HB(p);
    for (int row = blockIdx.x * 8 + wid; row < NTOK; row += gridDim.x * 8) {
        const float4* xr = (const float4*)(p.x + (size_t)row * DM);
        float4 v[8]; float ss = 0.f;
#pragma unroll
        for (int i = 0; i < 8; ++i) { v[i] = xr[i * 64 + lane]; ss += v[i].x * v[i].x + v[i].y * v[i].y + v[i].z * v[i].z + v[i].w * v[i].w; }
        ss = wave_sum(ss);
        const float rstd = rsqrtf(ss * (1.0f / DM) + EPSF);
#pragma unroll
        for (int i = 0; i < 8; ++i) { const float4 w = ((const float4*)p.norm_w)[i * 64 + lane];
            u32x2 o; o.x = cvt_pk_bf16(v[i].x * rstd * w.x, v[i].y * rstd * w.y); o.y = cvt_pk_bf16(v[i].z * rstd * w.z, v[i].w * rstd * w.w);
            *(u32x2*)(H + (size_t)row * DM + i * 256 + lane * 4) = o; }
    }
}
__device__ void transpose_tile(const float* src, int K, int N, int kt, int nt, bf16_t* dst, int mode, float* tile) {
    const int tid = threadIdx.x;
#pragma unroll
    for (int e = tid; e < 1024; e += 512) { const int r = e >> 4, c4 = e & 15; const int n = nt * 64 + c4 * 4; float4 v = make_float4(0.f, 0.f, 0.f, 0.f);
        if (n < N) v = *(const float4*)(src + (size_t)(kt * 64 + r) * N + n);
        float* t = tile + r * 65 + c4 * 4; t[0] = v.x; t[1] = v.y; t[2] = v.z; t[3] = v.w; }
    __syncthreads();
    { const int n = tid >> 3, kg = tid & 7; const int ng = nt * 64 + n;
      if (ng < N) { int dn = ng; if (mode == 1) dn = ng < 4096 ? ng : (ng < 4112 ? 12288 + (ng - 4096) : ng - 16);
          float f[8];
#pragma unroll
          for (int j = 0; j < 8; ++j) f[j] = tile[(kg * 8 + j) * 65 + n];
          *(u32x4*)(dst + (size_t)dn * K + kt * 64 + kg * 8) = pack8(f); } }
    __syncthreads();
}
__device__ void p0_rope_table(const Params& p) {
    for (int i = blockIdx.x * 512 + threadIdx.x; i < SEQ * 64; i += gridDim.x * 512) {
        const int pos = i >> 6, f = i & 63; const float invf = exp2f(-(float)(2 * f) * (13.287712379549449f / 128.0f));
        float sn, cs; sincosf((float)pos * invf, &sn, &cs); ROPE(p)[i] = make_float2(cs, sn); }
}
__device__ void p0_transposes(const Params& p, float* tile) {
    const int n0 = 32 * 193, n1 = n0 + 512, n2 = n1 + 512, n3 = n2 + 1024;
    for (int t = blockIdx.x; t < n3; t += gridDim.x) {
        if (t < n0) transpose_tile(p.w_in, 2048, INC, t / 193, t % 193, WinT(p), 1, tile);
        else if (t < n1) { const int u = t - n0; transpose_tile(p.w_out_gdn, 1024, 2048, u / 32, u % 32, WgT(p), 0, tile); }
        else if (t < n2) { const int u = t - n1; transpose_tile(p.w_out_moba, 1024, 2048, u / 32, u % 32, WmT(p), 0, tile); }
        else { const int u = t - n2; transpose_tile(p.w_o, 2048, 2048, u / 32, u % 32, WoT(p), 0, tile); }
    }
}

__device__ void p1_skinny(const Params& p, float* red) {
    const int wid = __builtin_amdgcn_readfirstlane(threadIdx.x >> 6), lane = threadIdx.x & 63, fr = lane & 15, g = lane >> 4;
    const bf16_t* H = HB(p); const bf16_t* Bt = WinT(p) + (size_t)12288 * 2048;
    for (int it = blockIdx.x; it < NTOK / 64; it += gridDim.x) {
        u32x4 bfr[8], afr[4][8];
        const bf16_t* bp = Bt + (size_t)fr * DM + wid * 256 + g * 8;
#pragma unroll
        for (int ks = 0; ks < 8; ++ks) bfr[ks] = *(const u32x4*)(bp + ks * 32);
#pragma unroll
        for (int rt = 0; rt < 4; ++rt) { const bf16_t* ap = H + (size_t)(it * 64 + rt * 16 + fr) * DM + wid * 256 + g * 8;
#pragma unroll
            for (int ks = 0; ks < 8; ++ks) afr[rt][ks] = *(const u32x4*)(ap + ks * 32); }
#pragma unroll
        for (int rt = 0; rt < 4; ++rt) { f32x4 acc = {0.f, 0.f, 0.f, 0.f};
#pragma unroll
            for (int ks = 0; ks < 8; ++ks) acc = MFMA16(as_bf8(afr[rt][ks]), as_bf8(bfr[ks]), acc);
            *(f32x4*)(red + ((wid * 4 + rt) * 64 + lane) * 4) = acc; }
        __syncthreads();
        if (wid < 4) { const int rt = wid; f32x4 acc = {0.f, 0.f, 0.f, 0.f};
#pragma unroll
            for (int w = 0; w < 8; ++w) acc += *(const f32x4*)(red + ((w * 4 + rt) * 64 + lane) * 4);
#pragma unroll
            for (int r = 0; r < 4; ++r) { const int tok = it * 64 + rt * 16 + g * 4 + r; const float v = acc[r];
                if (fr < 8) BETA(p)[tok * 8 + fr] = sigmoidf_(v);
                else { const int hh = fr - 8; const float z = v + p.dt_bias[hh]; const float sp = z > 20.f ? z : log1pf(expf(z)); GLOG(p)[tok * 8 + hh] = -expf(p.a_log[hh]) * sp; } } }
        __syncthreads();
    }
}

__device__ void p2_gdn_prep(const Params& p, unsigned char* lds) {
    constexpr int RS = 132, TS = 17;
    float* kf = (float*)lds; float* vf = (float*)(lds + 33792); bf16_t* qb = (bf16_t*)(lds + 67584); bf16_t* kb = (bf16_t*)(lds + 84992);
    float* Af = (float*)(lds + 102400); float* cum = (float*)(lds + 119808); float* sbeta = (float*)(lds + 120064); float* fac = (float*)(lds + 120320);
    constexpr int AS = 68;
    float* Td = (float*)(lds + 120832);
    const int tid = threadIdx.x, wid = __builtin_amdgcn_readfirstlane(tid >> 6), lane = tid & 63, fr = lane & 15, g = lane >> 4;
    const float scale = 0.08838834764831845f;
    float pg = 0.f, pb = 0.f;
#define GDN_CID(it_) ((((it_) & 255) >> 3) * 64 + (((it_) & 7) * 8 + ((it_) >> 8)))
    if (wid == 0 && (int)blockIdx.x < 2048) { const int c0_ = GDN_CID((int)blockIdx.x); const int t0_ = ((c0_ >> 6) >> 3) * SEQ + (c0_ & 63) * 64; pg = GLOG(p)[(t0_ + lane) * 8 + ((c0_ >> 6) & 7)]; pb = BETA(p)[(t0_ + lane) * 8 + ((c0_ >> 6) & 7)]; }
    int hcur = -1; float wreg[4][8];
#pragma unroll
    for (int j = 0; j < 4; ++j)
#pragma unroll
        for (int e = 0; e < 8; ++e) wreg[j][e] = 0.f;
    for (int it = blockIdx.x; it < 2048; it += gridDim.x) {
        const int cid = GDN_CID(it);
        const int bh = cid >> 6, n = cid & 63, b = bh >> 3, h = bh & 7;
        if (wid == 0) { float v = pg; const float be = pb;
            { const int c1_ = it + (int)gridDim.x < 2048 ? GDN_CID(it + (int)gridDim.x) : cid; const int t1_ = ((c1_ >> 6) >> 3) * SEQ + (c1_ & 63) * 64; pg = GLOG(p)[(t1_ + lane) * 8 + ((c1_ >> 6) & 7)]; pb = BETA(p)[(t1_ + lane) * 8 + ((c1_ >> 6) & 7)]; }
#pragma unroll
            for (int d = 1; d < 64; d <<= 1) { const float t = __shfl_up(v, d, 64); if (lane >= d) v += t; }
            cum[lane] = v; sbeta[lane] = be; fac[lane] = be * __expf(v); }
        __syncthreads();
        if (tid < 384) { const int s = wid >> 1, cg = tid & 15, tb8 = (tid >> 4) & 7, c0 = cg * 8;
            if (h != hcur) {
#pragma unroll
                for (int j = 0; j < 4; ++j) { const float* cw = p.conv_w + j * 3072 + s * 1024 + h * 128 + c0; const float4 w0 = *(const float4*)cw, w1 = *(const float4*)(cw + 4);
                    wreg[j][0] = w0.x; wreg[j][1] = w0.y; wreg[j][2] = w0.z; wreg[j][3] = w0.w; wreg[j][4] = w1.x; wreg[j][5] = w1.y; wreg[j][6] = w1.z; wreg[j][7] = w1.w; } }
#pragma unroll 1
            for (int hh2 = 0; hh2 < 2; ++hh2) {
            float rows[7][8];
            { const bf16_t* src = P_sec(p, s) + h * 128 + c0;
#pragma unroll
              for (int rr = 0; rr < 7; ++rr) { const int pos = n * 64 + tb8 * 8 + hh2 * 4 - 3 + rr; u32x4 rv = {0u, 0u, 0u, 0u};
                  if (pos >= 0) rv = *(const u32x4*)(src + (size_t)(b * SEQ + pos) * 1024);
                  unpack8(rv, rows[rr]); } }
#pragma unroll
            for (int tk = 0; tk < 4; ++tk) { const int tok = tb8 * 8 + hh2 * 4 + tk; float a[8]; float ss = 0.f;
#pragma unroll
                for (int e = 0; e < 8; ++e) { float v = wreg[0][e] * rows[tk][e]; v += wreg[1][e] * rows[tk + 1][e]; v += wreg[2][e] * rows[tk + 2][e]; v += wreg[3][e] * rows[tk + 3][e];
                    a[e] = siluf_(v); ss += a[e] * a[e]; }
                if (s < 2) { ss += __shfl_xor(ss, 1, 64); ss += __shfl_xor(ss, 2, 64); ss += __shfl_xor(ss, 4, 64); ss += __shfl_xor(ss, 8, 64); const float rn = rsqrtf(ss + EPSF);
#pragma unroll
                    for (int e = 0; e < 8; ++e) a[e] *= rn; }
                if (s == 0) { *(u32x4*)(qb + tok * 136 + c0) = pack8(a);
                    const float fq_ = scale * __expf(cum[tok]); float d[8];
#pragma unroll
                    for (int e = 0; e < 8; ++e) d[e] = a[e] * fq_;
                    *(u32x4*)(QDB(p) + ((size_t)cid * 64 + tok) * 128 + c0) = pack8(d); }
                else if (s == 1) { *(u32x4*)(kb + tok * 136 + c0) = pack8(a);
                    *(float4*)(kf + tok * RS + c0) = make_float4(a[0], a[1], a[2], a[3]); *(float4*)(kf + tok * RS + c0 + 4) = make_float4(a[4], a[5], a[6], a[7]); }
                else { *(float4*)(vf + tok * RS + c0) = make_float4(a[0], a[1], a[2], a[3]); *(float4*)(vf + tok * RS + c0 + 4) = make_float4(a[4], a[5], a[6], a[7]); }
            }
            }
        }
        hcur = h;
        __syncthreads();
        { const int mat = wid >> 2, mi = wid & 3; const bf16_t* xb = mat ? qb : kb;
          bf16x8 xfrag[4];
#pragma unroll
          for (int ks = 0; ks < 4; ++ks) xfrag[ks] = as_bf8(*(const u32x4*)(xb + (mi * 16 + fr) * 136 + ks * 32 + g * 8));
          const int i = mi * 16 + fr; const float ci = cum[i], bi = sbeta[i];
#pragma unroll
          for (int nj = 0; nj < 4; ++nj) {
              f32x4 acc = {0.f, 0.f, 0.f, 0.f};
              if (nj <= mi) {
#pragma unroll
                  for (int ks = 0; ks < 4; ++ks) { const bf16x8 kfrag = as_bf8(*(const u32x4*)(kb + (nj * 16 + fr) * 136 + ks * 32 + g * 8)); acc = MFMA16(kfrag, xfrag[ks], acc); } }
              float o[4];
#pragma unroll
              for (int r = 0; r < 4; ++r) { const int j = nj * 16 + g * 4 + r; const float dec = __expf(fminf(ci - cum[j], 0.f));
                  if (mat == 0) o[r] = (i > j) ? bi * acc[r] * dec : 0.f; else o[r] = (i >= j) ? scale * acc[r] * dec : 0.f; }
              if (mat == 0) *(float4*)(Af + i * AS + nj * 16 + g * 4) = make_float4(o[0], o[1], o[2], o[3]);
              else { u32x2 w; w.x = cvt_pk_bf16(o[0], o[1]); w.y = cvt_pk_bf16(o[2], o[3]); *(u32x2*)(QKB(p) + ((size_t)cid * 64 + i) * 64 + nj * 16 + g * 4) = w; }
          } }
        __syncthreads();
        if (wid == 0) { const int tb_ = lane >> 4, tc_ = lane & 15; const float* ab = Af + (tb_ * 16) * AS + tb_ * 16; float t[16];
#pragma unroll
            for (int i = 0; i < 16; ++i) { float v = (i == tc_) ? 1.f : 0.f;
#pragma unroll
                for (int j = 0; j < i; ++j) v -= ab[i * AS + j] * t[j];
                t[i] = v; Td[(tb_ * 16 + i) * TS + tc_] = v; } }
        { const float cl = cum[63];
#pragma unroll
          for (int rep = 0; rep < 2; ++rep) { const int task = tid + rep * 512; const int dk = task & 127, tg = task >> 7; float f[8];
#pragma unroll
              for (int j = 0; j < 8; ++j) f[j] = kf[(tg * 8 + j) * RS + dk] * __expf(cl - cum[tg * 8 + j]);
              *(u32x4*)(KDT(p) + ((size_t)cid * 128 + dk) * 64 + tg * 8) = pack8(f); }
          if (tid == 256) GLAST(p)[cid * 32] = __expf(cl); }
        __syncthreads();
        {
          float* src0 = (wid < 4 ? vf : kf) + ((wid * 2) & 7) * 16; float* src1 = src0 + 16; const float* fc = wid < 4 ? sbeta : fac;
#pragma unroll 1
          for (int bi = 0; bi < 4; ++bi) {
              f32x4 C0, C1;
#pragma unroll
              for (int r = 0; r < 4; ++r) { const float fr_ = fc[bi * 16 + g * 4 + r]; C0[r] = src0[(bi * 16 + g * 4 + r) * RS + fr] * fr_; C1[r] = src1[(bi * 16 + g * 4 + r) * RS + fr] * fr_; }
              for (int kb = 0; kb < 4 * bi; ++kb) { const float av = -Af[(bi * 16 + fr) * AS + kb * 4 + g];
                  C0 = __builtin_amdgcn_mfma_f32_16x16x4f32(av, src0[(kb * 4 + g) * RS + fr], C0, 0, 0, 0);
                  C1 = __builtin_amdgcn_mfma_f32_16x16x4f32(av, src1[(kb * 4 + g) * RS + fr], C1, 0, 0, 0); }
#pragma unroll
              for (int r = 0; r < 4; ++r) { src0[(bi * 16 + g * 4 + r) * RS + fr] = C0[r]; src1[(bi * 16 + g * 4 + r) * RS + fr] = C1[r]; }
              __builtin_amdgcn_wave_barrier();
              f32x4 D0 = {0.f, 0.f, 0.f, 0.f}, D1 = {0.f, 0.f, 0.f, 0.f};
#pragma unroll
              for (int kb = 0; kb < 4; ++kb) { const float tv = Td[(bi * 16 + fr) * TS + kb * 4 + g];
                  D0 = __builtin_amdgcn_mfma_f32_16x16x4f32(tv, src0[(bi * 16 + kb * 4 + g) * RS + fr], D0, 0, 0, 0);
                  D1 = __builtin_amdgcn_mfma_f32_16x16x4f32(tv, src1[(bi * 16 + kb * 4 + g) * RS + fr], D1, 0, 0, 0); }
              __builtin_amdgcn_wave_barrier();
#pragma unroll
              for (int r = 0; r < 4; ++r) { src0[(bi * 16 + g * 4 + r) * RS + fr] = D0[r]; src1[(bi * 16 + g * 4 + r) * RS + fr] = D1[r]; }
              __builtin_amdgcn_wave_barrier();
          }
        }
        __syncthreads();
#pragma unroll
        for (int rep = 0; rep < 4; ++rep) { const int e = tid + rep * 512; const int which = e >> 10, i = (e >> 4) & 63, c8 = (e & 15) * 8; const float* src = (which ? kf : vf) + i * RS + c8;
            const float4 x0 = *(const float4*)src, x1 = *(const float4*)(src + 4); const float fv[8] = {x0.x, x0.y, x0.z, x0.w, x1.x, x1.y, x1.z, x1.w};
            *(u32x4*)((which ? WB(p) : UB(p)) + (size_t)cid * 8192 + i * 128 + c8) = pack8(fv); }
    }
    __syncthreads();
}

__device__ void p2_moba_prep(const Params& p, unsigned char* lds) {
    bf16_t* vt = (bf16_t*)lds; float* part = (float*)(lds + 69632);
    const int tid = threadIdx.x, slot = tid >> 4, j = tid & 15;
    float qw[8], kw[8];
#pragma unroll
    for (int e = 0; e < 8; ++e) { qw[e] = p.qn_w[8 * j + e]; kw[e] = p.kn_w[8 * j + e]; }
    for (int it = blockIdx.x; it < 512; it += gridDim.x) {
        const int h = it & 7, blk = (it >> 3) & 15, b = it >> 7; const int tbase = b * SEQ + blk * 256;
        float ks[8];
#pragma unroll
        for (int e = 0; e < 8; ++e) ks[e] = 0.f;
        for (int pass = 0; pass < 8; ++pass) {
            const int tokl = pass * 32 + slot; const size_t off = (size_t)(tbase + tokl) * 1024 + h * 128 + 8 * j; const int pos = blk * 256 + tokl;
            float cs[8], sn[8];
            { const float4* rp = (const float4*)(ROPE(p) + pos * 64 + 8 * (j & 7));
#pragma unroll
              for (int e2 = 0; e2 < 4; ++e2) { const float4 t = rp[e2]; cs[2 * e2] = t.x; sn[2 * e2] = t.y; cs[2 * e2 + 1] = t.z; sn[2 * e2 + 1] = t.w; } }
#pragma unroll
            for (int s = 0; s < 2; ++s) { bf16_t* ptr = P_sec(p, 4 + s) + off; float f[8]; unpack8(*(const u32x4*)ptr, f); float ss = 0.f;
#pragma unroll
                for (int e = 0; e < 8; ++e) ss += f[e] * f[e];
                ss += __shfl_xor(ss, 1, 64); ss += __shfl_xor(ss, 2, 64); ss += __shfl_xor(ss, 4, 64); ss += __shfl_xor(ss, 8, 64);
                const float rstd = rsqrtf(ss * (1.0f / 128.0f) + EPSF); float o[8];
#pragma unroll
                for (int e = 0; e < 8; ++e) { const float y = f[e] * rstd * (s ? kw[e] : qw[e]); const float pr = __shfl_xor(y, 8, 64);
                    o[e] = (j < 8) ? (y * cs[e] - pr * sn[e]) : (y * cs[e] + pr * sn[e]); if (s) ks[e] += o[e]; }
                *(u32x4*)ptr = pack8(o); }
            *(u32x4*)(vt + tokl * 136 + 8 * j) = *(const u32x4*)(P_sec(p, 6) + off);
        }
#pragma unroll
        for (int e = 0; e < 8; ++e) part[slot * 128 + 8 * j + e] = ks[e];
        __syncthreads();
        if (tid < 128) { float s = 0.f;
#pragma unroll
            for (int q = 0; q < 32; ++q) s += part[q * 128 + tid];
            KMEAN(p)[(((size_t)b * 8 + h) * 16 + blk) * 128 + tid] = s * (1.0f / 256.0f); }
#pragma unroll
        for (int rep = 0; rep < 8; ++rep) { const int task = tid + rep * 512; const int dv = task & 127, tg = task >> 7; u32x4 w;
            unsigned short e0 = vt[(tg * 8 + 0) * 136 + dv], e1 = vt[(tg * 8 + 1) * 136 + dv], e2 = vt[(tg * 8 + 2) * 136 + dv], e3 = vt[(tg * 8 + 3) * 136 + dv];
            unsigned short e4 = vt[(tg * 8 + 4) * 136 + dv], e5 = vt[(tg * 8 + 5) * 136 + dv], e6 = vt[(tg * 8 + 6) * 136 + dv], e7 = vt[(tg * 8 + 7) * 136 + dv];
            w.x = e0 | ((unsigned)e1 << 16); w.y = e2 | ((unsigned)e3 << 16); w.z = e4 | ((unsigned)e5 << 16); w.w = e6 | ((unsigned)e7 << 16);
            *(u32x4*)(VT(p) + (((size_t)b * 8 + h) * 128 + dv) * SEQ + blk * 256 + tg * 8) = w; }
        __syncthreads();
    }
}

template <int NT>
__device__ void p3_gdn_scan(const Params& p, unsigned char* lds) {
    bf16_t* ST_s = (bf16_t*)lds; bf16_t* vT_s = (bf16_t*)(lds + NT * 4352);
    const int tid = threadIdx.x, wid = __builtin_amdgcn_readfirstlane(tid >> 6), lane = tid & 63, fr = lane & 15, g = lane >> 4;
    const int mt = wid & 3;
    for (int vb = blockIdx.x; vb < 256 / NT; vb += gridDim.x) {
        const int bh = vb / (8 / NT), slq = vb % (8 / NT);
        f32x4 Sacc[NT];
#pragma unroll
        for (int j = 0; j < NT; ++j) { Sacc[j] = (f32x4){0.f, 0.f, 0.f, 0.f}; u32x2 z; z.x = 0u; z.y = 0u; *(u32x2*)(ST_s + (j * 16 + fr) * 136 + wid * 16 + g * 4) = z; }
        const bf16_t* abase = (wid < 4 ? WB(p) : QDB(p)) + (mt * 16 + fr) * 128 + g * 8;
        const bf16_t* kbase = KDT(p) + (wid * 16 + fr) * 64 + g * 8;
        const bf16_t* qkbase = QKB(p) + (mt * 16 + fr) * 64 + g * 8;
        const bf16_t* ubase = UB(p) + (mt * 16 + g * 4) * 128 + slq * NT * 16 + fr;
        u32x4 a4A[4], a4B[4], kAA[2], kAB[2], qkA[2], qkB[2]; bf16_t uvA[NT][4], uvB[NT][4]; float glA, glB;
#define SLOADA(cid_) do { const int _cid = (cid_); const bf16_t* _ab = abase + (size_t)_cid * 8192; \
            _Pragma("unroll") for (int ks = 0; ks < 4; ++ks) a4A[ks] = *(const u32x4*)(_ab + ks * 32); \
            kAA[0] = *(const u32x4*)(kbase + (size_t)_cid * 8192); kAA[1] = *(const u32x4*)(kbase + (size_t)_cid * 8192 + 32); glA = GLAST(p)[_cid * 32]; \
            qkA[0] = *(const u32x4*)(qkbase + (size_t)_cid * 4096); qkA[1] = *(const u32x4*)(qkbase + (size_t)_cid * 4096 + 32); \
            _Pragma("unroll") for (int j = 0; j < NT; ++j) _Pragma("unroll") for (int r = 0; r < 4; ++r) uvA[j][r] = ubase[(size_t)_cid * 8192 + r * 128 + j * 16]; } while (0)
#define SLOADB(cid_) do { const int _cid = (cid_); const bf16_t* _ab = abase + (size_t)_cid * 8192; \
            _Pragma("unroll") for (int ks = 0; ks < 4; ++ks) a4B[ks] = *(const u32x4*)(_ab + ks * 32); \
            kAB[0] = *(const u32x4*)(kbase + (size_t)_cid * 8192); kAB[1] = *(const u32x4*)(kbase + (size_t)_cid * 8192 + 32); glB = GLAST(p)[_cid * 32]; \
            qkB[0] = *(const u32x4*)(qkbase + (size_t)_cid * 4096); qkB[1] = *(const u32x4*)(qkbase + (size_t)_cid * 4096 + 32); \
            _Pragma("unroll") for (int j = 0; j < NT; ++j) _Pragma("unroll") for (int r = 0; r < 4; ++r) uvB[j][r] = ubase[(size_t)_cid * 8192 + r * 128 + j * 16]; } while (0)
        SLOADA(bh * 64); SLOADB(bh * 64 + 1);
        __syncthreads();
#pragma unroll 1
        for (int n = 0; n < 64; n += 2) {
            { const int nn = n;
            f32x4 acc[NT];
#pragma unroll
            for (int j = 0; j < NT; ++j) { acc[j] = (f32x4){0.f, 0.f, 0.f, 0.f};
#pragma unroll
                for (int ks = 0; ks < 4; ++ks) acc[j] = MFMA16(as_bf8(a4A[ks]), as_bf8(*(const u32x4*)(ST_s + (j * 16 + fr) * 136 + g * 8 + ks * 32)), acc[j]); }
            if (wid < 4) {
#pragma unroll
                for (int j = 0; j < NT; ++j) { float vn[4];
#pragma unroll
                    for (int r = 0; r < 4; ++r) vn[r] = bf2f(uvA[j][r]) - acc[j][r];
                    u32x2 w; w.x = cvt_pk_bf16(vn[0], vn[1]); w.y = cvt_pk_bf16(vn[2], vn[3]); *(u32x2*)(vT_s + (j * 16 + fr) * 72 + mt * 16 + g * 4) = w; } }
            const float gl = glA; const u32x4 k0 = kAA[0], k1 = kAA[1], q0 = qkA[0], q1 = qkA[1];
            SLOADA(bh * 64 + (nn + 2 < 64 ? nn + 2 : 63));
            __syncthreads();
#pragma unroll
            for (int j = 0; j < NT; ++j) {
                const bf16x8 vf0 = as_bf8(*(const u32x4*)(vT_s + (j * 16 + fr) * 72 + g * 8)), vf1 = as_bf8(*(const u32x4*)(vT_s + (j * 16 + fr) * 72 + 32 + g * 8));
                if (wid >= 4) {
                    acc[j] = MFMA16(as_bf8(q0), vf0, acc[j]); acc[j] = MFMA16(as_bf8(q1), vf1, acc[j]);
                    float* op = OGDN(p) + ((size_t)(bh * 8 + slq * NT + j) * SEQ + nn * 64 + mt * 16 + g * 4) * 16 + fr;
#pragma unroll
                    for (int r = 0; r < 4; ++r) op[r * 16] = acc[j][r];
                }
                Sacc[j] *= gl;
                Sacc[j] = MFMA16(as_bf8(k0), vf0, Sacc[j]); Sacc[j] = MFMA16(as_bf8(k1), vf1, Sacc[j]);
                { u32x2 w; w.x = cvt_pk_bf16(Sacc[j][0], Sacc[j][1]); w.y = cvt_pk_bf16(Sacc[j][2], Sacc[j][3]); *(u32x2*)(ST_s + (j * 16 + fr) * 136 + wid * 16 + g * 4) = w; }
            }
            __syncthreads();
            }
            { const int nn = (n + 1);
            f32x4 acc[NT];
#pragma unroll
            for (int j = 0; j < NT; ++j) { acc[j] = (f32x4){0.f, 0.f, 0.f, 0.f};
#pragma unroll
                for (int ks = 0; ks < 4; ++ks) acc[j] = MFMA16(as_bf8(a4B[ks]), as_bf8(*(const u32x4*)(ST_s + (j * 16 + fr) * 136 + g * 8 + ks * 32)), acc[j]); }
            if (wid < 4) {
#pragma unroll
                for (int j = 0; j < NT; ++j) { float vn[4];
#pragma unroll
                    for (int r = 0; r < 4; ++r) vn[r] = bf2f(uvB[j][r]) - acc[j][r];
                    u32x2 w; w.x = cvt_pk_bf16(vn[0], vn[1]); w.y = cvt_pk_bf16(vn[2], vn[3]); *(u32x2*)(vT_s + (j * 16 + fr) * 72 + mt * 16 + g * 4) = w; } }
            const float gl = glB; const u32x4 k0 = kAB[0], k1 = kAB[1], q0 = qkB[0], q1 = qkB[1];
            SLOADB(bh * 64 + (nn + 2 < 64 ? nn + 2 : 63));
            __syncthreads();
#pragma unroll
            for (int j = 0; j < NT; ++j) {
                const bf16x8 vf0 = as_bf8(*(const u32x4*)(vT_s + (j * 16 + fr) * 72 + g * 8)), vf1 = as_bf8(*(const u32x4*)(vT_s + (j * 16 + fr) * 72 + 32 + g * 8));
                if (wid >= 4) {
                    acc[j] = MFMA16(as_bf8(q0), vf0, acc[j]); acc[j] = MFMA16(as_bf8(q1), vf1, acc[j]);
                    float* op = OGDN(p) + ((size_t)(bh * 8 + slq * NT + j) * SEQ + nn * 64 + mt * 16 + g * 4) * 16 + fr;
#pragma unroll
                    for (int r = 0; r < 4; ++r) op[r * 16] = acc[j][r];
                }
                Sacc[j] *= gl;
                Sacc[j] = MFMA16(as_bf8(k0), vf0, Sacc[j]); Sacc[j] = MFMA16(as_bf8(k1), vf1, Sacc[j]);
                { u32x2 w; w.x = cvt_pk_bf16(Sacc[j][0], Sacc[j][1]); w.y = cvt_pk_bf16(Sacc[j][2], Sacc[j][3]); *(u32x2*)(ST_s + (j * 16 + fr) * 136 + wid * 16 + g * 4) = w; }
            }
            __syncthreads();
            }
        }
    }
#undef SLOADA
#undef SLOADB
    if ((int)blockIdx.x < 256 / NT) {
        asm volatile("s_waitcnt vmcnt(0) lgkmcnt(0)" ::: "memory");
        __syncthreads();
        if (threadIdx.x < 64) { __builtin_amdgcn_fence(__ATOMIC_RELEASE, "agent"); asm volatile("s_waitcnt vmcnt(0)" ::: "memory");
            if (threadIdx.x == 0) { int nit = 0; for (int vb = blockIdx.x; vb < 256 / NT; vb += gridDim.x) ++nit; __hip_atomic_fetch_add(BARCTR(p) + 32, (unsigned)nit, __ATOMIC_RELAXED, __HIP_MEMORY_SCOPE_AGENT); } }
    }
}

__device__ void p3_moba_attn(const Params& p, unsigned char* lds) {
    const int tid = threadIdx.x, wid = __builtin_amdgcn_readfirstlane(tid >> 6), lane = tid & 63, fr = lane & 15, g = lane >> 4;
    const float scale2 = 0.08838834764831845f * 1.4426950408889634f;
    const bf16_t* MQ = P_sec(p, 4); const bf16_t* MK = P_sec(p, 5); const bf16_t* MZ = P_sec(p, 7);
    bf16_t* Kb = (bf16_t*)lds;
    bf16_t* Vb = (bf16_t*)(lds + 34816);
    float* gsc = (float*)(lds + 71680) + wid * 512;
    float B2;
    { float mq = fmaxf(fabsf(p.qn_w[lane]), fabsf(p.qn_w[lane + 64])), mk = fmaxf(fabsf(p.kn_w[lane]), fabsf(p.kn_w[lane + 64]));
#pragma unroll
      for (int d = 32; d >= 1; d >>= 1) { mq = fmaxf(mq, __shfl_xor(mq, d, 64)); mk = fmaxf(mk, __shfl_xor(mk, d, 64)); }
      B2 = 128.0f * mq * mk * scale2 * 1.02f; }
    int* slot = (int*)(lds + 126976); unsigned* qctr = BARCTR(p) + 16;
    for (;;) {
        __syncthreads();
        if (tid == 0) *slot = (int)__hip_atomic_fetch_add(qctr, 1u, __ATOMIC_RELAXED, __HIP_MEMORY_SCOPE_AGENT);
        __syncthreads();
        const int item = __builtin_amdgcn_readfirstlane(*slot);
        if (item >= 512) break;
        const int bh = item & 31, b = bh >> 3, h = bh & 7; const size_t tb = (size_t)b * SEQ;
        const bf16_t* vtb = VT(p) + ((size_t)bh * 128) * SEQ;
        {
            const int blk = 15 - (item >> 5); const int qoff = wid * 32, q0 = blk * 256 + qoff;
            bf16x8 qf[2][4];
#pragma unroll
            for (int t = 0; t < 2; ++t)
#pragma unroll
                for (int ks = 0; ks < 4; ++ks) qf[t][ks] = as_bf8(*(const u32x4*)(MQ + (tb + q0 + t * 16 + fr) * 1024 + h * 128 + ks * 32 + g * 8));
            unsigned mymask = (1u << blk) - 1u;
            if (blk > 3) {
                f32x4 ga0 = {0.f, 0.f, 0.f, 0.f}, ga1 = {0.f, 0.f, 0.f, 0.f};
                const float* km = KMEAN(p) + ((size_t)bh * 16 + fr) * 128 + g * 8;
#pragma unroll
                for (int ks = 0; ks < 4; ++ks) { const float4 x0 = *(const float4*)(km + ks * 32), x1 = *(const float4*)(km + ks * 32 + 4);
                    const float xs[8] = {x0.x, x0.y, x0.z, x0.w, x1.x, x1.y, x1.z, x1.w}; float hi[8], lo[8];
#pragma unroll
                    for (int e = 0; e < 8; ++e) { hi[e] = __uint_as_float(__float_as_uint(xs[e]) & 0xffff0000u); lo[e] = xs[e] - hi[e]; }
                    const bf16x8 khi = as_bf8(pack8(hi)), klo = as_bf8(pack8(lo));
                    ga0 = MFMA16(khi, qf[0][ks], ga0); ga0 = MFMA16(klo, qf[0][ks], ga0); ga1 = MFMA16(khi, qf[1][ks], ga1); ga1 = MFMA16(klo, qf[1][ks], ga1); }
#pragma unroll
                for (int r = 0; r < 4; ++r) { gsc[(g * 4 + r) * 32 + fr] = ga0[r]; gsc[(g * 4 + r) * 32 + 16 + fr] = ga1[r]; }
                __builtin_amdgcn_wave_barrier();
                float ga[16];
#pragma unroll
                for (int jb = 0; jb < 16; ++jb) ga[jb] = gsc[jb * 32 + (lane & 31)];
                __builtin_amdgcn_wave_barrier();
                unsigned m = 0u;
#pragma unroll
                for (int s3 = 0; s3 < 3; ++s3) { float best = -INFINITY; int bi = -1;
#pragma unroll
                    for (int jb = 0; jb < 16; ++jb) { const bool ok = (jb < blk) && !((m >> jb) & 1u); if (ok && (ga[jb] > best || bi < 0)) { best = ga[jb]; bi = jb; } }
                    if (bi >= 0) m |= 1u << bi; }
                mymask = m;
            }
            unsigned um = mymask, am = mymask;
#pragma unroll
            for (int d = 16; d >= 1; d >>= 1) { um |= __shfl_xor(um, d, 64); am &= __shfl_xor(am, d, 64); }
            unsigned qmask[2]; qmask[0] = __shfl(mymask, fr, 64); qmask[1] = __shfl(mymask, 16 + fr, 64);
            f32x4 O[2][8];
#pragma unroll
            for (int t = 0; t < 2; ++t)
#pragma unroll
                for (int d = 0; d < 8; ++d) O[t][d] = (f32x4){0.f, 0.f, 0.f, 0.f};
            float lrun[2] = {0.f, 0.f};
            const int nst = (blk + 1) * 4;
            const bf16_t* kg = MK + (tb + (tid >> 3)) * 1024 + h * 128 + (tid & 7) * 16; const bf16_t* vg = vtb + (size_t)(tid >> 2) * SEQ + (tid & 3) * 16;
            bf16_t* kl = Kb + (tid >> 3) * 136 + (tid & 7) * 16; bf16_t* vl = Vb + (tid >> 2) * 72 + (tid & 3) * 16;
            u32x4 rk0 = *(const u32x4*)kg, rk1 = *(const u32x4*)(kg + 8), rv0 = *(const u32x4*)vg, rv1 = *(const u32x4*)(vg + 8);
            for (int st = 0; st < nst; ++st) {
                const int buf = st & 1;
                *(u32x4*)(kl + buf * 8704) = rk0; *(u32x4*)(kl + buf * 8704 + 8) = rk1; *(u32x4*)(vl + buf * 9216) = rv0; *(u32x4*)(vl + buf * 9216 + 8) = rv1;
                __syncthreads();
                if (st + 1 < nst) { const size_t ko = (size_t)(st + 1) * 64; rk0 = *(const u32x4*)(kg + ko * 1024); rk1 = *(const u32x4*)(kg + ko * 1024 + 8); rv0 = *(const u32x4*)(vg + ko); rv1 = *(const u32x4*)(vg + ko + 8); }
                const int jb = st >> 2; const bool own = (jb == blk);
                if (!own && !((um >> jb) & 1u)) continue;
                const bf16_t* Ks = Kb + buf * 8704; const bf16_t* Vs = Vb + buf * 9216;
#pragma unroll 1
                for (int sub = 0; sub < 2; ++sub) {
                    const int kin = (st & 3) * 64 + sub * 32;
                    if (own && kin > qoff + 31) break;
                    const bool needmask = own ? (kin + 31 > qoff) : !((am >> jb) & 1u);
                    f32x4 sc[2][2];
#pragma unroll
                    for (int t = 0; t < 2; ++t)
#pragma unroll
                        for (int kt = 0; kt < 2; ++kt) sc[t][kt] = (f32x4){0.f, 0.f, 0.f, 0.f};
#pragma unroll
                    for (int kt = 0; kt < 2; ++kt) { const bf16_t* kp = Ks + (sub * 32 + kt * 16 + fr) * 136 + g * 8;
#pragma unroll
                        for (int ks = 0; ks < 4; ++ks) { const bf16x8 kfr = as_bf8(*(const u32x4*)(kp + ks * 32));
                            sc[0][kt] = MFMA16(kfr, qf[0][ks], sc[0][kt]); sc[1][kt] = MFMA16(kfr, qf[1][ks], sc[1][kt]); } }
                    bf16x8 pf[2];
#pragma unroll
                    for (int t = 0; t < 2; ++t) {
                        float pv[8];
#pragma unroll
                        for (int kt = 0; kt < 2; ++kt)
#pragma unroll
                            for (int r = 0; r < 4; ++r) pv[kt * 4 + r] = __builtin_amdgcn_exp2f(__builtin_fmaf(sc[t][kt][r], scale2, -B2));
                        if (needmask) {
                            const bool sel = own || ((qmask[t] >> jb) & 1u);
#pragma unroll
                            for (int kt = 0; kt < 2; ++kt)
#pragma unroll
                                for (int r = 0; r < 4; ++r) { bool ok = sel; if (own) ok = (kin + kt * 16 + g * 4 + r) <= (qoff + t * 16 + fr); pv[kt * 4 + r] = ok ? pv[kt * 4 + r] : 0.f; } }
                        lrun[t] += ((pv[0] + pv[1]) + (pv[2] + pv[3])) + ((pv[4] + pv[5]) + (pv[6] + pv[7]));
                        pf[t] = as_bf8(pack8(pv));
                    }
#pragma unroll
                    for (int d = 0; d < 8; ++d) { const bf16_t* vp = Vs + (d * 16 + fr) * 72 + sub * 32 + g * 4;
                        const u32x2 v0 = *(const u32x2*)vp, v1 = *(const u32x2*)(vp + 16); u32x4 vv; vv.x = v0.x; vv.y = v0.y; vv.z = v1.x; vv.w = v1.y; const bf16x8 vfr = as_bf8(vv);
                        O[0][d] = MFMA16(vfr, pf[0], O[0][d]); O[1][d] = MFMA16(vfr, pf[1], O[1][d]); }
                }
            }
#pragma unroll
            for (int t = 0; t < 2; ++t) { float l = lrun[t]; l += __shfl_xor(l, 16, 64); l += __shfl_xor(l, 32, 64); const float inv = __builtin_amdgcn_rcpf(l);
                const size_t ro = (tb + q0 + t * 16 + fr) * 1024 + h * 128 + g * 4;
#pragma unroll
                for (int d = 0; d < 8; ++d) { const u32x2 zz = *(const u32x2*)(MZ + ro + d * 16); const float z0 = bflo(zz.x), z1 = bfhi(zz.x), z2 = bflo(zz.y), z3 = bfhi(zz.y);
                    u32x2 w; w.x = cvt_pk_bf16(O[t][d][0] * inv * siluf_(z0), O[t][d][1] * inv * siluf_(z1)); w.y = cvt_pk_bf16(O[t][d][2] * inv * siluf_(z2), O[t][d][3] * inv * siluf_(z3));
                    *(u32x2*)(OB(p) + ro + d * 16) = w; } }
        }
    }
    __syncthreads();
}

__device__ void p4_gdn_post(const Params& p) {
    const int j = threadIdx.x & 15; const bf16_t* GZ = P_sec(p, 3);
    float nw[8];
#pragma unroll
    for (int e = 0; e < 8; ++e) nw[e] = p.gdn_norm_w[8 * j + e];
    for (int pr = blockIdx.x * 32 + (threadIdx.x >> 4); pr < NTOK * 8; pr += gridDim.x * 32) {
        const size_t off = (size_t)pr * 128 + 8 * j;
        const int tok = pr >> 3, hh = pr & 7; const size_t goff = ((((size_t)(tok >> 12) * 8 + hh) * 8 + (j >> 1)) * SEQ + (tok & 4095)) * 16 + (j & 1) * 8;
        const float4 a = *(const float4*)(OGDN(p) + goff), c = *(const float4*)(OGDN(p) + goff + 4);
        float f[8] = {a.x, a.y, a.z, a.w, c.x, c.y, c.z, c.w}; float ss = 0.f;
#pragma unroll
        for (int e = 0; e < 8; ++e) ss += f[e] * f[e];
        ss += __shfl_xor(ss, 1, 64); ss += __shfl_xor(ss, 2, 64); ss += __shfl_xor(ss, 4, 64); ss += __shfl_xor(ss, 8, 64);
        const float rstd = rsqrtf(ss * (1.0f / 128.0f) + EPSF); float z[8]; unpack8(*(const u32x4*)(GZ + off), z); float o[8];
#pragma unroll
        for (int e = 0; e < 8; ++e) o[e] = f[e] * rstd * nw[e] * siluf_(z[e]);
        *(u32x4*)(OA(p) + off) = pack8(o);
    }
}

__device__ void p4_gdn_post_items(const Params& p, unsigned char* lds, int n_scan_items) {
    const int tid = threadIdx.x, j = tid & 15; const bf16_t* GZ = P_sec(p, 3);
    int* slot = (int*)(lds + 126976); unsigned* done = BARCTR(p) + 32; unsigned* q2 = BARCTR(p) + 48;
    if (tid < 64) { if (tid == 0) { while (__hip_atomic_load(done, __ATOMIC_RELAXED, __HIP_MEMORY_SCOPE_AGENT) < (unsigned)n_scan_items) __builtin_amdgcn_s_sleep(2); }
        __builtin_amdgcn_fence(__ATOMIC_ACQUIRE, "agent"); asm volatile("s_waitcnt vmcnt(0)" ::: "memory"); }
    float nw[8];
#pragma unroll
    for (int e = 0; e < 8; ++e) nw[e] = p.gdn_norm_w[8 * j + e];
    for (;;) {
        __syncthreads();
        if (tid == 0) *slot = (int)__hip_atomic_fetch_add(q2, 1u, __ATOMIC_RELAXED, __HIP_MEMORY_SCOPE_AGENT);
        __syncthreads();
        const int item = __builtin_amdgcn_readfirstlane(*slot);
        if (item >= 512) break;
#pragma unroll 2
        for (int k = 0; k < 8; ++k) { const int pr = item * 256 + k * 32 + (tid >> 4);
            const size_t off = (size_t)pr * 128 + 8 * j;
            const int tok = pr >> 3, hh = pr & 7; const size_t goff = ((((size_t)(tok >> 12) * 8 + hh) * 8 + (j >> 1)) * SEQ + (tok & 4095)) * 16 + (j & 1) * 8;
            const float4 a = *(const float4*)(OGDN(p) + goff), c = *(const float4*)(OGDN(p) + goff + 4);
            float f[8] = {a.x, a.y, a.z, a.w, c.x, c.y, c.z, c.w}; float ss = 0.f;
#pragma unroll
            for (int e = 0; e < 8; ++e) ss += f[e] * f[e];
            ss += __shfl_xor(ss, 1, 64); ss += __shfl_xor(ss, 2, 64); ss += __shfl_xor(ss, 4, 64); ss += __shfl_xor(ss, 8, 64);
            const float rstd = rsqrtf(ss * (1.0f / 128.0f) + EPSF); float z[8]; unpack8(*(const u32x4*)(GZ + off), z); float o[8];
#pragma unroll
            for (int e = 0; e < 8; ++e) o[e] = f[e] * rstd * nw[e] * siluf_(z[e]);
            *(u32x4*)(OA(p) + off) = pack8(o); }
    }
}

__device__ __forceinline__ void grid_barrier(unsigned* ctr, unsigned& target) {
    asm volatile("s_waitcnt vmcnt(0) lgkmcnt(0)" ::: "memory");
    __syncthreads();
    target += gridDim.x;
    if (threadIdx.x < 64) {
        __builtin_amdgcn_fence(__ATOMIC_RELEASE, "agent");
        asm volatile("s_waitcnt vmcnt(0)" ::: "memory");
        if (threadIdx.x == 0) {
            __hip_atomic_fetch_add(ctr, 1u, __ATOMIC_RELAXED, __HIP_MEMORY_SCOPE_AGENT);
            while (__hip_atomic_load(ctr, __ATOMIC_RELAXED, __HIP_MEMORY_SCOPE_AGENT) < target) __builtin_amdgcn_s_sleep(1);
        }
        __builtin_amdgcn_fence(__ATOMIC_ACQUIRE, "agent");
        asm volatile("s_waitcnt vmcnt(0)" ::: "memory");
    }
    __syncthreads();
}

__device__ void dbg_dump(const Params& p, const bf16_t* a, const bf16_t* b) {
    for (size_t i = (size_t)blockIdx.x * 512 + threadIdx.x; i < (size_t)NTOK * 256; i += (size_t)gridDim.x * 512) {
        const size_t r = i >> 8; const int c8 = (int)(i & 255) * 8; const bf16_t* src = (c8 < 1024 ? a : b) + r * 1024 + (c8 & 1023);
        float f[8]; unpack8(*(const u32x4*)src, f);
        *(float4*)(p.out + r * 2048 + c8) = make_float4(f[0], f[1], f[2], f[3]); *(float4*)(p.out + r * 2048 + c8 + 4) = make_float4(f[4], f[5], f[6], f[7]); }
}

__global__ void __launch_bounds__(512, 2) fwd_megakernel(Params p) {
    extern __shared__ __attribute__((aligned(16))) unsigned char shm[];
    cg::grid_group grid = cg::this_grid();
    unsigned* bctr = BARCTR(p); unsigned btarget = 0u;
    PG8_LAS unsigned char* lds = (PG8_LAS unsigned char*)shm;
    const int G = (int)gridDim.x, c = (int)blockIdx.x;
#ifndef PHM
#define PHM 0xff
#endif
    p0_rope_table(p);
    p0_rows(p);
    p0_transposes(p, (float*)shm);
    grid_barrier(bctr, btarget);
    { p1_skinny(p, (float*)shm);
    { pg8::StaticOrder S; S.init(NTOK, 12288, G, c); pg8::Gemm gm{HB(p), WinT(p), NTOK, 12288, 2048, HB(p), WinT(p)}; Epi1 E{(bf16_t*)p.ws};
      pg8::gemm_phase<Epi1, pg8::StaticOrder, false>(lds, gm, S, E, nullptr); } }
    grid_barrier(bctr, btarget);
    p2_gdn_prep(p, shm);
    p2_moba_prep(p, shm);
    grid_barrier(bctr, btarget);
#if DBG == 2
    dbg_dump(p, P_sec(p, 4), P_sec(p, 5)); return;
#elif DBG == 3
    dbg_dump(p, P_sec(p, 0), P_sec(p, 3)); return;
#elif DBG == 4 || DBG == 5
    { const u32x4* s0 = (const u32x4*)(DBG == 4 ? UB(p) : QDB(p)); const u32x4* s1 = (const u32x4*)(DBG == 4 ? WB(p) : KDT(p)); u32x4* d0 = (u32x4*)OB(p); u32x4* d1 = (u32x4*)VT(p);
      for (size_t i = (size_t)blockIdx.x * 512 + threadIdx.x; i < (size_t)2097152; i += (size_t)gridDim.x * 512) { d0[i] = s0[i]; d1[i] = s1[i]; }
      grid_barrier(bctr, btarget); dbg_dump(p, OB(p), VT(p)); return; }
#endif
    p3_gdn_scan<SCAN_NT>(p, shm);
    p3_moba_attn(p, shm);
    p4_gdn_post_items(p, shm, 256 / SCAN_NT);
    grid_barrier(bctr, btarget);
#if DBG == 1
    dbg_dump(p, OA(p), OB(p)); return;
#elif DBG == 7
    dbg_dump(p, OA(p), OA(p)); return;
#elif DBG == 8
    dbg_dump(p, OB(p), OB(p)); return;
#endif
    { pg8::StaticOrder S; S.init(NTOK, 2048, G, c);
      PairOrder PO; PO.base = S; pg8::Gemm gm{OA(p), WgT(p), NTOK, 2048, 1024, OB(p), WmT(p)}; Epi2 E{MERGED(p), P_sec(p, 8), P_sec(p, 10)};
      pg8::gemm_phase<Epi2, PairOrder, false>(lds, gm, PO, E, nullptr); }
    grid_barrier(bctr, btarget);
    { pg8::StaticOrder S; S.init(NTOK, 2048, G, c); pg8::Gemm gm{MERGED(p), WoT(p), NTOK, 2048, 2048, MERGED(p), WoT(p)}; Epi3 E{p.out, p.x};
      pg8::gemm_phase<Epi3, pg8::StaticOrder, false>(lds, gm, S, E, nullptr); }
}

extern "C" void kernel_launch(void* const* d_in, const int* in_sizes, int n_in, void* d_out, int out_size, void* d_ws, size_t ws_size, hipStream_t stream) {
    constexpr size_t kDynLds = 131072;
    static int grid_blocks = 0;
    if (!grid_blocks) {
        int dev = 0, cus = 0, per_cu = 0;
        hipGetDevice(&dev);
        hipDeviceGetAttribute(&cus, hipDeviceAttributeMultiprocessorCount, dev);
        hipFuncSetAttribute((const void*)fwd_megakernel, hipFuncAttributeMaxDynamicSharedMemorySize, (int)kDynLds);
        hipOccupancyMaxActiveBlocksPerMultiprocessor(&per_cu, fwd_megakernel, 512, kDynLds);
        if (per_cu < 1) per_cu = 1;
        grid_blocks = cus * per_cu;
        if (grid_blocks > 256) grid_blocks = 256;
    }
    Params p{};
    p.x = (const float*)d_in[0]; p.norm_w = (const float*)d_in[1]; p.w_in = (const float*)d_in[2]; p.conv_w = (const float*)d_in[3];
    p.a_log = (const float*)d_in[4]; p.dt_bias = (const float*)d_in[5]; p.gdn_norm_w = (const float*)d_in[6]; p.qn_w = (const float*)d_in[7]; p.kn_w = (const float*)d_in[8];
    p.w_out_gdn = (const float*)d_in[9]; p.w_out_moba = (const float*)d_in[10]; p.w_o = (const float*)d_in[11];
    p.out = (float*)d_out; p.ws = (unsigned char*)d_ws;
    hipMemsetAsync((unsigned char*)d_ws + (size_t)482 * 1048576, 0, 256, stream);
    void* args[] = {&p};
    hipError_t e = hipLaunchCooperativeKernel((void*)fwd_megakernel, dim3(grid_blocks), dim3(512), args, kDynLds, stream);
    if (e != hipSuccess) fprintf(stderr, "cooperative launch failed: %s (grid %d)\n", hipGetErrorString(e), grid_blocks);
}
```

```cpp
#include <hip/hip_runtime.h>
#include <hip/hip_cooperative_groups.h>
#include <cstdio>
#define SCAN_NT 4
namespace cg = cooperative_groups;
namespace pg8 {
#define PG8_LAS __attribute__((address_space(3)))
typedef unsigned short bf16_t;
typedef short bf16x8 __attribute__((ext_vector_type(8)));
typedef float f32x4 __attribute__((ext_vector_type(4)));
typedef unsigned u32x4 __attribute__((ext_vector_type(4)));
constexpr int BM = 256, BK = 64, HALF = 128, HTB = HALF * BK * 2  , STAGE_BYTES = 8 * HTB, NXCD = 8, WGM = 8;

__host__ __device__ __forceinline__ int lds_byte(int r, int c) { const int st = (r >> 4) * 2 + (c >> 5), rr = r & 15, cc = c & 31, ob = rr * 64 + cc * 2; return st * 1024 + (ob ^ (((ob >> 9) & 1) << 5)); }
__host__ __device__ __forceinline__ void stage_rc(int b, int& R, int& C) { const int st = b / 1024, sb = b % 1024, swz = sb ^ (((sb >> 9) & 1) << 5); R = (st >> 1) * 16 + swz / 64; C = (st & 1) * 32 + (swz % 64) / 2; }
__host__ __device__ __forceinline__ int perm32(int rho) { const int n = rho >> 4, i = rho & 15; return 8 * (i >> 2) + 4 * n + (i & 3); }

struct Unit { int pm, pn, pass; };
struct Gemm { const bf16_t* A; const bf16_t* Bt; int M, N, K; const bf16_t* A2; const bf16_t* Bt2; };

struct StaticOrder {
    int nM, nN, nwg, G, c;
    __host__ __device__ void init(int M, int N, int G_, int c_) { nM = M / BM; nN = N / BM; nwg = nM * nN; G = G_; c = c_; }
    __host__ __device__ bool next(int i, Unit& u) const {
        const long L = (long)i * G + c; if (L >= nwg) return false;
        int wgid = (int)L; { const int q = nwg / NXCD, r = nwg % NXCD, xcd = wgid % NXCD, off = wgid / NXCD; wgid = (xcd < r ? xcd * (q + 1) : r * (q + 1) + (xcd - r) * q) + off; }
        const int nig = WGM * nN, gid = wgid / nig, fm = gid * WGM, gsz = (nM - fm) < WGM ? (nM - fm) : WGM;
        u.pm = fm + ((wgid % nig) % gsz); u.pn = (wgid % nig) / gsz; u.pass = 0; return true;
    }
    __device__ __forceinline__ void a_ready(const Unit&) const {}
    __device__ __forceinline__ void done(const Unit&) const {}
};
typedef __bf16 bf16v2_t __attribute__((ext_vector_type(2)));
__device__ __forceinline__ unsigned cvt_pk_bf16(float lo, float hi) { bf16v2_t v; v.x = (__bf16)lo; v.y = (__bf16)hi; return __builtin_bit_cast(unsigned, v); }
template <class Epi, class Sched, bool STAMP = false>
__device__ __forceinline__ void gemm_phase(PG8_LAS unsigned char* lds, const Gemm g, const Sched& S, const Epi& E, unsigned long long* stamps) {
    const int tid = threadIdx.x, wid = __builtin_amdgcn_readfirstlane(tid >> 6), lane = tid & 63, wr = wid >> 2, wc = wid & 3, fr = lane & 15, fq = lane >> 4;
    const int K = g.K, nt = K / BK;
    int ts_lo = 0, ts_hi = 0, nts = 0; const unsigned long long rt_entry = STAMP ? (unsigned long long)wall_clock64() : 0ull;
#define PG8_STAMP() do { if (STAMP && wid == 0 && nts < 64) { const unsigned long long _c = (unsigned long long)clock64(); \
        ts_lo = (lane == nts) ? (int)(unsigned)_c : ts_lo; ts_hi = (lane == nts) ? (int)(unsigned)(_c >> 32) : ts_hi; ++nts; } } while (0)
    PG8_STAMP();
    unsigned voffA[2], voffB[2];
#pragma unroll
    for (int i = 0; i < 2; ++i) { int R, C; stage_rc(tid * 16 + i * 8192, R, C); const int Rb = Epi::PERM ? ((R & ~31) + perm32(R & 31)) : R;
        voffA[i] = (unsigned)(R * K + C) * 2u; voffB[i] = (unsigned)(Rb * K + C) * 2u; }
    const size_t kstep = (size_t)(BK * 2);
    const size_t hstep = (size_t)HALF * K * 2;
    const size_t tstep = 2 * hstep;
    const unsigned ldsw = (unsigned)wid * 1024u;
    const int aoff = lds_byte(wr * 64 + fr, fq * 8), boff = lds_byte(wc * 32 + fr, fq * 8);
#define PG8_SA(b, h) (((b) * 2 + (h)) * HTB)
#define PG8_SB(b, h) ((4 + (b) * 2 + (h)) * HTB)
#define PG8_STAGE(bufoff, gbase, voff) do { _Pragma("unroll") for (int _i = 0; _i < 2; ++_i) \
        __builtin_amdgcn_global_load_lds((const unsigned*)((const char*)(gbase) + (voff)[_i]), (PG8_LAS unsigned*)(lds + (bufoff) + ldsw + _i * 8192), 16, 0, 0); } while (0)
#define PG8_LDA(dst, b, h) do { _Pragma("unroll") for (int m = 0; m < 4; ++m) _Pragma("unroll") for (int k = 0; k < 2; ++k) dst[m][k] = *(const PG8_LAS bf16x8*)(lds + PG8_SA(b, h) + aoff + m * 2048 + k * 1024); } while (0)
#define PG8_LDB(dst, b, h) do { _Pragma("unroll") for (int n = 0; n < 2; ++n) _Pragma("unroll") for (int k = 0; k < 2; ++k) dst[n][k] = *(const PG8_LAS bf16x8*)(lds + PG8_SB(b, h) + boff + n * 2048 + k * 1024); } while (0)
#define PG8_MMA(ai, bj, At, Bt) do { __builtin_amdgcn_s_setprio(1); _Pragma("unroll") for (int m = 0; m < 4; ++m) _Pragma("unroll") for (int n = 0; n < 2; ++n) _Pragma("unroll") for (int k = 0; k < 2; ++k) \
        acc[ai][bj][m][n] = __builtin_amdgcn_mfma_f32_16x16x32_bf16(Bt[n][k], At[m][k], acc[ai][bj][m][n], 0, 0, 0); __builtin_amdgcn_s_setprio(0); } while (0)
#define PG8_WAIT_V(n) asm volatile("s_waitcnt vmcnt(" #n ")" ::: "memory")
#define PG8_WAIT_L(n) asm volatile("s_waitcnt lgkmcnt(" #n ")" ::: "memory")
#define PG8_BAR __builtin_amdgcn_s_barrier()
#define PG8_SCHED __builtin_amdgcn_sched_barrier(0)
    Unit cur, nxt; int ui = 0;
    if (!S.next(0, cur)) return;
    f32x4 acc[2][2][4][2];
#pragma unroll
    for (int a = 0; a < 2; ++a)
#pragma unroll
        for (int b = 0; b < 2; ++b)
#pragma unroll
            for (int m = 0; m < 4; ++m)
#pragma unroll
                for (int n = 0; n < 2; ++n) acc[a][b][m][n] = (f32x4){0.f, 0.f, 0.f, 0.f};
    bf16x8 At[4][2], B0[2][2], B1[2][2];
    const char* cA = (const char*)(cur.pass ? g.A2 : g.A) + (size_t)cur.pm * tstep; const char* cB = (const char*)(cur.pass ? g.Bt2 : g.Bt) + (size_t)cur.pn * tstep;
    S.a_ready(cur);
    PG8_STAGE(PG8_SB(0, 0), cB, voffB); PG8_STAGE(PG8_SA(0, 0), cA, voffA); PG8_STAGE(PG8_SB(0, 1), cB + hstep, voffB); PG8_STAGE(PG8_SA(0, 1), cA + hstep, voffA);
    if (wr == 1) PG8_BAR;
    PG8_WAIT_V(4); PG8_BAR;
    PG8_STAGE(PG8_SB(1, 0), cB + kstep, voffB); PG8_STAGE(PG8_SA(1, 0), cA + kstep, voffA); PG8_STAGE(PG8_SB(1, 1), cB + hstep + kstep, voffB);
    PG8_WAIT_V(6); PG8_BAR;
    PG8_STAMP();
    for (;;) {
        const bool has_next = S.next(ui + 1, nxt);
        const char* nA = has_next ? (const char*)(nxt.pass ? g.A2 : g.A) + (size_t)nxt.pm * tstep : cA; const char* nB = has_next ? (const char*)(nxt.pass ? g.Bt2 : g.Bt) + (size_t)nxt.pn * tstep : cB;
        for (int t = 0; t < nt; t += 2) {
            const bool last = (t == nt - 2);
            const char* a1 = cA + (size_t)(t + 1) * kstep;
            const char* a2 = last ? nA : cA + (size_t)(t + 2) * kstep; const char* b2 = last ? nB : cB + (size_t)(t + 2) * kstep;
            const char* a3 = a2 + kstep; const char* b3 = b2 + kstep;
            if (last && has_next) S.a_ready(nxt);
            PG8_LDB(B0, 0, 0); PG8_SCHED; PG8_LDA(At, 0, 0); PG8_STAGE(PG8_SA(1, 1), a1 + hstep, voffA);
            PG8_WAIT_L(8); PG8_BAR; PG8_WAIT_L(0); PG8_MMA(0, 0, At, B0); PG8_BAR; PG8_SCHED;
            PG8_LDB(B1, 0, 1); PG8_STAGE(PG8_SB(0, 0), b2, voffB);
            PG8_BAR; PG8_WAIT_L(0); PG8_MMA(0, 1, At, B1); PG8_BAR;
            PG8_LDA(At, 0, 1); PG8_STAGE(PG8_SA(0, 0), a2, voffA);
            PG8_BAR; PG8_WAIT_L(0); PG8_MMA(1, 0, At, B0); PG8_BAR; PG8_SCHED;
            PG8_STAGE(PG8_SB(0, 1), b2 + hstep, voffB);
            PG8_WAIT_V(6); PG8_BAR; PG8_MMA(1, 1, At, B1); PG8_BAR;
            PG8_LDB(B0, 1, 0); PG8_SCHED; PG8_LDA(At, 1, 0); PG8_STAGE(PG8_SA(0, 1), a2 + hstep, voffA);
            PG8_WAIT_L(8); PG8_BAR; PG8_WAIT_L(0); PG8_MMA(0, 0, At, B0); PG8_BAR; PG8_SCHED;
            PG8_LDB(B1, 1, 1); PG8_STAGE(PG8_SB(1, 0), b3, voffB);
            PG8_BAR; PG8_WAIT_L(0); PG8_MMA(0, 1, At, B1); PG8_BAR;
            PG8_LDA(At, 1, 1); PG8_STAGE(PG8_SA(1, 0), a3, voffA);
            PG8_BAR; PG8_WAIT_L(0); PG8_MMA(1, 0, At, B0); PG8_BAR; PG8_SCHED;
            PG8_STAGE(PG8_SB(1, 1), b3 + hstep, voffB);
            PG8_WAIT_V(6); PG8_BAR; PG8_MMA(1, 1, At, B1); PG8_BAR;
        }
        PG8_STAMP();
        if constexpr (!Epi::AFTER_DRAIN) { E(acc, cur, wr, wc, fr, fq); S.done(cur); }
        PG8_STAMP();
        if (!has_next) break;
#pragma unroll
        for (int a = 0; a < 2; ++a)
#pragma unroll
            for (int b = 0; b < 2; ++b)
#pragma unroll
                for (int m = 0; m < 4; ++m)
#pragma unroll
                    for (int n = 0; n < 2; ++n) acc[a][b][m][n] = (f32x4){0.f, 0.f, 0.f, 0.f};
        cur = nxt; cA = nA; cB = nB; ++ui;
    }
    PG8_WAIT_V(0);
    if (wr == 0) PG8_BAR;
    PG8_BAR;
    if constexpr (Epi::AFTER_DRAIN) { E.fused(acc, cur, wr, wc, fr, fq, lds, wid, lane); S.done(cur); }
    PG8_STAMP();
    if (STAMP && wid == 0) { stamps[lane] = lane < nts ? (((unsigned long long)(unsigned)ts_hi << 32) | (unsigned)ts_lo) : 0ull;
        if (lane == 62) stamps[62] = rt_entry; if (lane == 63) stamps[63] = (unsigned long long)wall_clock64(); }
#undef PG8_STAMP
#undef PG8_SA
#undef PG8_SB
#undef PG8_STAGE
#undef PG8_LDA
#undef PG8_LDB
#undef PG8_MMA
#undef PG8_WAIT_V
#undef PG8_WAIT_L
#undef PG8_BAR
#undef PG8_SCHED
}
}
#ifndef DBG
#define DBG 0
#endif
#ifndef SCAN_NT
#define SCAN_NT 2
#endif
#ifndef REP
#define REP 0
#endif
using pg8::bf16_t; using pg8::bf16x8; using pg8::f32x4; using pg8::u32x4; using pg8::cvt_pk_bf16;
typedef unsigned u32x2 __attribute__((ext_vector_type(2)));

constexpr int NTOK = 16384, DM = 2048, SEQ = 4096, NH = 8, HD = 128, INC = 12304;
constexpr float EPSF = 1e-6f;
constexpr size_t MIB = 1048576;
constexpr size_t SEC = (size_t)NTOK * 1024;

struct Params {
    const float *x, *norm_w, *w_in, *conv_w, *a_log, *dt_bias, *gdn_norm_w, *qn_w, *kn_w, *w_out_gdn, *w_out_moba, *w_o;
    float* out; unsigned char* ws;
};

__device__ __forceinline__ bf16_t* P_sec(const Params& p, int s) { return (bf16_t*)p.ws + (size_t)s * SEC; }
__device__ __forceinline__ bf16_t* WgT(const Params& p) { return (bf16_t*)(p.ws + 384 * MIB); }
__device__ __forceinline__ bf16_t* WmT(const Params& p) { return (bf16_t*)(p.ws + 388 * MIB); }
__device__ __forceinline__ bf16_t* WoT(const Params& p) { return (bf16_t*)(p.ws + 392 * MIB); }
__device__ __forceinline__ float* BETA(const Params& p) { return (float*)(p.ws + 400 * MIB); }
__device__ __forceinline__ float* GLOG(const Params& p) { return (float*)(p.ws + 400 * MIB + 524288); }
__device__ __forceinline__ float* KMEAN(const Params& p) { return (float*)(p.ws + 401 * MIB); }
__device__ __forceinline__ float* GLAST(const Params& p) { return (float*)(p.ws + 401 * MIB + 524288); }
__device__ __forceinline__ bf16_t* QKB(const Params& p) { return (bf16_t*)(p.ws + 402 * MIB); }
__device__ __forceinline__ bf16_t* OB(const Params& p) { return (bf16_t*)(p.ws + 418 * MIB); }
__device__ __forceinline__ bf16_t* VT(const Params& p) { return (bf16_t*)(p.ws + 450 * MIB); }
__device__ __forceinline__ unsigned* BARCTR(const Params& p) { return (unsigned*)(p.ws + 482 * MIB); }
__device__ __forceinline__ float2* ROPE(const Params& p) { return (float2*)(p.ws + 484 * MIB); }
__device__ __forceinline__ float* OGDN(const Params& p) { return (float*)p.ws; }
__device__ __forceinline__ bf16_t* OA(const Params& p) { return P_sec(p, 2); }
__device__ __forceinline__ bf16_t* MERGED(const Params& p) { return P_sec(p, 4); }
__device__ __forceinline__ bf16_t* HB(const Params& p) { return (bf16_t*)p.out; }
__device__ __forceinline__ bf16_t* WinT(const Params& p) { return (bf16_t*)((unsigned char*)p.out + 64 * MIB); }
__device__ __forceinline__ bf16_t* UB(const Params& p) { return (bf16_t*)p.out; }
__device__ __forceinline__ bf16_t* WB(const Params& p) { return (bf16_t*)((unsigned char*)p.out + 32 * MIB); }
__device__ __forceinline__ bf16_t* QDB(const Params& p) { return (bf16_t*)((unsigned char*)p.out + 64 * MIB); }
__device__ __forceinline__ bf16_t* KDT(const Params& p) { return (bf16_t*)((unsigned char*)p.out + 96 * MIB); }

__device__ __forceinline__ float bf2f(unsigned short b) { return __uint_as_float(((unsigned)b) << 16); }
__device__ __forceinline__ float bflo(unsigned w) { return __uint_as_float(w << 16); }
__device__ __forceinline__ float bfhi(unsigned w) { return __uint_as_float(w & 0xffff0000u); }
__device__ __forceinline__ bf16x8 as_bf8(u32x4 v) { return __builtin_bit_cast(bf16x8, v); }
__device__ __forceinline__ float sigmoidf_(float v) { return __builtin_amdgcn_rcpf(1.0f + __expf(-v)); }
__device__ __forceinline__ float siluf_(float v) { return v * __builtin_amdgcn_rcpf(1.0f + __expf(-v)); }
__device__ __forceinline__ void unpack8(u32x4 v, float* f) { f[0] = bflo(v.x); f[1] = bfhi(v.x); f[2] = bflo(v.y); f[3] = bfhi(v.y); f[4] = bflo(v.z); f[5] = bfhi(v.z); f[6] = bflo(v.w); f[7] = bfhi(v.w); }
__device__ __forceinline__ u32x4 pack8(const float* f) { u32x4 w; w.x = cvt_pk_bf16(f[0], f[1]); w.y = cvt_pk_bf16(f[2], f[3]); w.z = cvt_pk_bf16(f[4], f[5]); w.w = cvt_pk_bf16(f[6], f[7]); return w; }
#define MFMA16(a, b, c) __builtin_amdgcn_mfma_f32_16x16x32_bf16((a), (b), (c), 0, 0, 0)

struct Epi1 {
    static constexpr bool PERM = true, AFTER_DRAIN = false;
    bf16_t* P;
    __device__ __forceinline__ void operator()(const f32x4 (&acc)[2][2][4][2], const pg8::Unit& u, int wr, int wc, int fr, int fq) const {
        const int row0 = u.pm * 256 + wr * 64 + fr; int colt = u.pn * 256; bf16_t* base = P + (size_t)(colt >> 10) * SEC; colt &= 1023;
        const int col0 = colt + wc * 32 + 8 * fq;
#pragma unroll
        for (int ai = 0; ai < 2; ++ai)
#pragma unroll
            for (int m = 0; m < 4; ++m) { bf16_t* rowp = base + (size_t)(row0 + ai * 128 + m * 16) * 1024 + col0;
#pragma unroll
                for (int bj = 0; bj < 2; ++bj) { const f32x4 v0 = acc[ai][bj][m][0], v1 = acc[ai][bj][m][1];
                    u32x4 w; w.x = cvt_pk_bf16(v0[0], v0[1]); w.y = cvt_pk_bf16(v0[2], v0[3]); w.z = cvt_pk_bf16(v1[0], v1[1]); w.w = cvt_pk_bf16(v1[2], v1[3]);
                    *(u32x4*)(rowp + bj * 128) = w; } }
    }
};
struct Epi2 {
    static constexpr bool PERM = true, AFTER_DRAIN = false;
    bf16_t* M; const bf16_t* G0; const bf16_t* G1;
    __device__ __forceinline__ void operator()(const f32x4 (&acc)[2][2][4][2], const pg8::Unit& u, int wr, int wc, int fr, int fq) const {
        const int row0 = u.pm * 256 + wr * 64 + fr; const int colt = u.pn * 256; const bool second = u.pass != 0;
        const bf16_t* gb = (second ? G1 : G0) + (size_t)(colt >> 10) * SEC + (colt & 1023) + wc * 32 + 8 * fq; bf16_t* mb = M + colt + wc * 32 + 8 * fq;
#pragma unroll
        for (int ai = 0; ai < 2; ++ai) {
            u32x4 gv[4][2], ov[4][2];
#pragma unroll
            for (int m = 0; m < 4; ++m)
#pragma unroll
                for (int bj = 0; bj < 2; ++bj) { const int row = row0 + ai * 128 + m * 16; gv[m][bj] = *(const u32x4*)(gb + (size_t)row * 1024 + bj * 128);
                    ov[m][bj] = second ? *(const u32x4*)(mb + (size_t)row * 2048 + bj * 128) : (u32x4){0u, 0u, 0u, 0u}; }
#pragma unroll
            for (int m = 0; m < 4; ++m)
#pragma unroll
                for (int bj = 0; bj < 2; ++bj) { const int row = row0 + ai * 128 + m * 16; const f32x4 v0 = acc[ai][bj][m][0], v1 = acc[ai][bj][m][1];
                    float g[8], old[8], o[8]; unpack8(gv[m][bj], g); unpack8(ov[m][bj], old);
#pragma unroll
                    for (int e = 0; e < 4; ++e) { o[e] = sigmoidf_(g[e]) * v0[e] + old[e]; o[4 + e] = sigmoidf_(g[4 + e]) * v1[e] + old[4 + e]; }
                    *(u32x4*)(mb + (size_t)row * 2048 + bj * 128) = pack8(o); }
        }
    }
};
struct PairOrder { pg8::StaticOrder base;
    __device__ bool next(int i, pg8::Unit& u) const { if (!base.next(i >> 1, u)) return false; u.pass = i & 1; return true; }
    __device__ __forceinline__ void a_ready(const pg8::Unit&) const {}
    __device__ __forceinline__ void done(const pg8::Unit&) const {}
};
struct Epi3 {
    static constexpr bool PERM = false, AFTER_DRAIN = false;
    float* O; const float* X;
    __device__ __forceinline__ void operator()(const f32x4 (&acc)[2][2][4][2], const pg8::Unit& u, int wr, int wc, int fr, int fq) const {
        const int row0 = u.pm * 256 + wr * 64 + fr, col0 = u.pn * 256 + wc * 32 + 4 * fq;
#pragma unroll
        for (int ai = 0; ai < 2; ++ai) {
            f32x4 xv[4][2][2];
#pragma unroll
            for (int m = 0; m < 4; ++m)
#pragma unroll
                for (int bj = 0; bj < 2; ++bj)
#pragma unroll
                    for (int n = 0; n < 2; ++n) xv[m][bj][n] = *(const f32x4*)(X + (size_t)(row0 + ai * 128 + m * 16) * DM + col0 + bj * 128 + n * 16);
#pragma unroll
            for (int m = 0; m < 4; ++m)
#pragma unroll
                for (int bj = 0; bj < 2; ++bj)
#pragma unroll
                    for (int n = 0; n < 2; ++n) *(f32x4*)(O + (size_t)(row0 + ai * 128 + m * 16) * DM + col0 + bj * 128 + n * 16) = acc[ai][bj][m][n] + xv[m][bj][n];
        }
    }
};

__device__ __forceinline__ float wave_sum(float v) {
#pragma unroll
    for (int d = 32; d >= 1; d >>= 1) v += __shfl_xor(v, d, 64);
    return v;
}
__device__ void p0_rows(const Params& p) {
    const int wid = __builtin_amdgcn_readfirstlane(threadIdx.x >> 6), lane = threadIdx.x & 63;
    bf16_t* H = HB(p);
    for (int row = blockIdx.x * 8 + wid; row < NTOK; row += gridDim.x * 8) {
        const float4* xr = (const float4*)(p.x + (size_t)row * DM);
        float4 v[8]; float ss = 0.f;
#pragma unroll
        for (int i = 0; i < 8; ++i) { v[i] = xr[i * 64 + lane]; ss += v[i].x * v[i].x + v[i].y * v[i].y + v[i].z * v[i].z + v[i].w * v[i].w; }
        ss = wave_sum(ss);
        const float rstd = rsqrtf(ss * (1.0f / DM) + EPSF);
#pragma unroll
        for (int i = 0; i < 8; ++i) { const float4 w = ((const float4*)p.norm_w)[i * 64 + lane];
            u32x2 o; o.x = cvt_pk_bf16(v[i].x * rstd * w.x, v[i].y * rstd * w.y); o.y = cvt_pk_bf16(v[i].z * rstd * w.z, v[i].w * rstd * w.w);
            *(u32x2*)(H + (size_t)row * DM + i * 256 + lane * 4) = o; }
    }
}
__device__ void transpose_tile(const float* src, int K, int N, int kt, int nt, bf16_t* dst, int mode, float* tile) {
    const int tid = threadIdx.x;
#pragma unroll
    for (int e = tid; e < 1024; e += 512) { const int r = e >> 4, c4 = e & 15; const int n = nt * 64 + c4 * 4; float4 v = make_float4(0.f, 0.f, 0.f, 0.f);
        if (n < N) v = *(const float4*)(src + (size_t)(kt * 64 + r) * N + n);
        float* t = tile + r * 65 + c4 * 4; t[0] = v.x; t[1] = v.y; t[2] = v.z; t[3] = v.w; }
    __syncthreads();
    { const int n = tid >> 3, kg = tid & 7; const int ng = nt * 64 + n;
      if (ng < N) { int dn = ng; if (mode == 1) dn = ng < 4096 ? ng : (ng < 4112 ? 12288 + (ng - 4096) : ng - 16);
          float f[8];
#pragma unroll
          for (int j = 0; j < 8; ++j) f[j] = tile[(kg * 8 + j) * 65 + n];
          *(u32x4*)(dst + (size_t)dn * K + kt * 64 + kg * 8) = pack8(f); } }
    __syncthreads();
}
__device__ void p0_rope_table(const Params& p) {
    for (int i = blockIdx.x * 512 + threadIdx.x; i < SEQ * 64; i += gridDim.x * 512) {
        const int pos = i >> 6, f = i & 63; const float invf = exp2f(-(float)(2 * f) * (13.287712379549449f / 128.0f));
        float sn, cs; sincosf((float)pos * invf, &sn, &cs); ROPE(p)[i] = make_float2(cs, sn); }
}
__device__ void p0_transposes(const Params& p, float* tile) {
    const int n0 = 32 * 193, n1 = n0 + 512, n2 = n1 + 512, n3 = n2 + 1024;
    for (int t = blockIdx.x; t < n3; t += gridDim.x) {
        if (t < n0) transpose_tile(p.w_in, 2048, INC, t / 193, t % 193, WinT(p), 1, tile);
        else if (t < n1) { const int u = t - n0; transpose_tile(p.w_out_gdn, 1024, 2048, u / 32, u % 32, WgT(p), 0, tile); }
        else if (t < n2) { const int u = t - n1; transpose_tile(p.w_out_moba, 1024, 2048, u / 32, u % 32, WmT(p), 0, tile); }
        else { const int u = t - n2; transpose_tile(p.w_o, 2048, 2048, u / 32, u % 32, WoT(p), 0, tile); }
    }
}

__device__ void p1_skinny(const Params& p, float* red) {
    const int wid = __builtin_amdgcn_readfirstlane(threadIdx.x >> 6), lane = threadIdx.x & 63, fr = lane & 15, g = lane >> 4;
    const bf16_t* H = HB(p); const bf16_t* Bt = WinT(p) + (size_t)12288 * 2048;
    for (int it = blockIdx.x; it < NTOK / 64; it += gridDim.x) {
        u32x4 bfr[8], afr[4][8];
        const bf16_t* bp = Bt + (size_t)fr * DM + wid * 256 + g * 8;
#pragma unroll
        for (int ks = 0; ks < 8; ++ks) bfr[ks] = *(const u32x4*)(bp + ks * 32);
#pragma unroll
        for (int rt = 0; rt < 4; ++rt) { const bf16_t* ap = H + (size_t)(it * 64 + rt * 16 + fr) * DM + wid * 256 + g * 8;
#pragma unroll
            for (int ks = 0; ks < 8; ++ks) afr[rt][ks] = *(const u32x4*)(ap + ks * 32); }
#pragma unroll
        for (int rt = 0; rt < 4; ++rt) { f32x4 acc = {0.f, 0.f, 0.f, 0.f};
#pragma unroll
            for (int ks = 0; ks < 8; ++ks) acc = MFMA16(as_bf8(afr[rt][ks]), as_bf8(bfr[ks]), acc);
            *(f32x4*)(red + ((wid * 4 + rt) * 64 + lane) * 4) = acc; }
        __syncthreads();
        if (wid < 4) { const int rt = wid; f32x4 acc = {0.f, 0.f, 0.f, 0.f};
#pragma unroll
            for (int w = 0; w < 8; ++w) acc += *(const f32x4*)(red + ((w * 4 + rt) * 64 + lane) * 4);
#pragma unroll
            for (int r = 0; r < 4; ++r) { const int tok = it * 64 + rt * 16 + g * 4 + r; const float v = acc[r];
                if (fr < 8) BETA(p)[tok * 8 + fr] = sigmoidf_(v);
                else { const int hh = fr - 8; const float z = v + p.dt_bias[hh]; const float sp = z > 20.f ? z : log1pf(expf(z)); GLOG(p)[tok * 8 + hh] = -expf(p.a_log[hh]) * sp; } } }
        __syncthreads();
    }
}

__device__ void p2_gdn_prep(const Params& p, unsigned char* lds) {
    constexpr int RS = 132, TS = 17;
    float* kf = (float*)lds; float* vf = (float*)(lds + 33792); bf16_t* qb = (bf16_t*)(lds + 67584); bf16_t* kb = (bf16_t*)(lds + 84992);
    float* Af = (float*)(lds + 102400); float* cum = (float*)(lds + 119808); float* sbeta = (float*)(lds + 120064); float* fac = (float*)(lds + 120320);
    constexpr int AS = 68;
    float* Td = (float*)(lds + 120832);
    const int tid = threadIdx.x, wid = __builtin_amdgcn_readfirstlane(tid >> 6), lane = tid & 63, fr = lane & 15, g = lane >> 4;
    const float scale = 0.08838834764831845f;
    float pg = 0.f, pb = 0.f;
#define GDN_CID(it_) ((((it_) & 255) >> 3) * 64 + (((it_) & 7) * 8 + ((it_) >> 8)))
    if (wid == 0 && (int)blockIdx.x < 2048) { const int c0_ = GDN_CID((int)blockIdx.x); const int t0_ = ((c0_ >> 6) >> 3) * SEQ + (c0_ & 63) * 64; pg = GLOG(p)[(t0_ + lane) * 8 + ((c0_ >> 6) & 7)]; pb = BETA(p)[(t0_ + lane) * 8 + ((c0_ >> 6) & 7)]; }
    int hcur = -1; float wreg[4][8];
#pragma unroll
    for (int j = 0; j < 4; ++j)
#pragma unroll
        for (int e = 0; e < 8; ++e) wreg[j][e] = 0.f;
    for (int it = blockIdx.x; it < 2048; it += gridDim.x) {
        const int cid = GDN_CID(it);
        const int bh = cid >> 6, n = cid & 63, b = bh >> 3, h = bh & 7;
        if (wid == 0) { float v = pg; const float be = pb;
            { const int c1_ = it + (int)gridDim.x < 2048 ? GDN_CID(it + (int)gridDim.x) : cid; const int t1_ = ((c1_ >> 6) >> 3) * SEQ + (c1_ & 63) * 64; pg = GLOG(p)[(t1_ + lane) * 8 + ((c1_ >> 6) & 7)]; pb = BETA(p)[(t1_ + lane) * 8 + ((c1_ >> 6) & 7)]; }
#pragma unroll
            for (int d = 1; d < 64; d <<= 1) { const float t = __shfl_up(v, d, 64); if (lane >= d) v += t; }
            cum[lane] = v; sbeta[lane] = be; fac[lane] = be * __expf(v); }
        __syncthreads();
        if (tid < 384) { const int s = wid >> 1, cg = tid & 15, tb8 = (tid >> 4) & 7, c0 = cg * 8;
            if (h != hcur) {
#pragma unroll
                for (int j = 0; j < 4; ++j) { const float* cw = p.conv_w + j * 3072 + s * 1024 + h * 128 + c0; const float4 w0 = *(const float4*)cw, w1 = *(const float4*)(cw + 4);
                    wreg[j][0] = w0.x; wreg[j][1] = w0.y; wreg[j][2] = w0.z; wreg[j][3] = w0.w; wreg[j][4] = w1.x; wreg[j][5] = w1.y; wreg[j][6] = w1.z; wreg[j][7] = w1.w; } }
#pragma unroll 1
            for (int hh2 = 0; hh2 < 2; ++hh2) {
            float rows[7][8];
            { const bf16_t* src = P_sec(p, s) + h * 128 + c0;
#pragma unroll
              for (int rr = 0; rr < 7; ++rr) { const int pos = n * 64 + tb8 * 8 + hh2 * 4 - 3 + rr; u32x4 rv = {0u, 0u, 0u, 0u};
                  if (pos >= 0) rv = *(const u32x4*)(src + (size_t)(b * SEQ + pos) * 1024);
                  unpack8(rv, rows[rr]); } }
#pragma unroll
            for (int tk = 0; tk < 4; ++tk) { const int tok = tb8 * 8 + hh2 * 4 + tk; float a[8]; float ss = 0.f;
#pragma unroll
                for (int e = 0; e < 8; ++e) { float v = wreg[0][e] * rows[tk][e]; v += wreg[1][e] * rows[tk + 1][e]; v += wreg[2][e] * rows[tk + 2][e]; v += wreg[3][e] * rows[tk + 3][e];
                    a[e] = siluf_(v); ss += a[e] * a[e]; }
                if (s < 2) { ss += __shfl_xor(ss, 1, 64); ss += __shfl_xor(ss, 2, 64); ss += __shfl_xor(ss, 4, 64); ss += __shfl_xor(ss, 8, 64); const float rn = rsqrtf(ss + EPSF);
#pragma unroll
                    for (int e = 0; e < 8; ++e) a[e] *= rn; }
                if (s == 0) { *(u32x4*)(qb + tok * 136 + c0) = pack8(a);
                    const float fq_ = scale * __expf(cum[tok]); float d[8];
#pragma unroll
                    for (int e = 0; e < 8; ++e) d[e] = a[e] * fq_;
                    *(u32x4*)(QDB(p) + ((size_t)cid * 64 + tok) * 128 + c0) = pack8(d); }
                else if (s == 1) { *(u32x4*)(kb + tok * 136 + c0) = pack8(a);
                    *(float4*)(kf + tok * RS + c0) = make_float4(a[0], a[1], a[2], a[3]); *(float4*)(kf + tok * RS + c0 + 4) = make_float4(a[4], a[5], a[6], a[7]); }
                else { *(float4*)(vf + tok * RS + c0) = make_float4(a[0], a[1], a[2], a[3]); *(float4*)(vf + tok * RS + c0 + 4) = make_float4(a[4], a[5], a[6], a[7]); }
            }
            }
        }
        hcur = h;
        __syncthreads();
        { const int mat = wid >> 2, mi = wid & 3; const bf16_t* xb = mat ? qb : kb;
          bf16x8 xfrag[4];
#pragma unroll
          for (int ks = 0; ks < 4; ++ks) xfrag[ks] = as_bf8(*(const u32x4*)(xb + (mi * 16 + fr) * 136 + ks * 32 + g * 8));
          const int i = mi * 16 + fr; const float ci = cum[i], bi = sbeta[i];
          for (int nj = 0; nj < 4; ++nj) {
              f32x4 acc = {0.f, 0.f, 0.f, 0.f};
              if (nj <= mi) {
#pragma unroll
                  for (int ks = 0; ks < 4; ++ks) { const bf16x8 kfrag = as_bf8(*(const u32x4*)(kb + (nj * 16 + fr) * 136 + ks * 32 + g * 8)); acc = MFMA16(kfrag, xfrag[ks], acc); } }
              float o[4];
#pragma unroll
              for (int r = 0; r < 4; ++r) { const int j = nj * 16 + g * 4 + r; const float dec = __expf(fminf(ci - cum[j], 0.f));
                  if (mat == 0) o[r] = (i > j) ? bi * acc[r] * dec : 0.f; else o[r] = (i >= j) ? scale * acc[r] * dec : 0.f; }
              if (mat == 0) *(float4*)(Af + i * AS + nj * 16 + g * 4) = make_float4(o[0], o[1], o[2], o[3]);
              else { u32x2 w; w.x = cvt_pk_bf16(o[0], o[1]); w.y = cvt_pk_bf16(o[2], o[3]); *(u32x2*)(QKB(p) + ((size_t)cid * 64 + i) * 64 + nj * 16 + g * 4) = w; }
          } }
        __syncthreads();
        if (wid == 0) { const int tb_ = lane >> 4, tc_ = lane & 15; const float* ab = Af + (tb_ * 16) * AS + tb_ * 16; float t[16];
#pragma unroll
            for (int i = 0; i < 16; ++i) { float v = (i == tc_) ? 1.f : 0.f;
#pragma unroll
                for (int j = 0; j < i; ++j) v -= ab[i * AS + j] * t[j];
                t[i] = v; Td[(tb_ * 16 + i) * TS + tc_] = v; } }
        { const float cl = cum[63];
#pragma unroll
          for (int rep = 0; rep < 2; ++rep) { const int task = tid + rep * 512; const int dk = task & 127, tg = task >> 7; float f[8];
#pragma unroll
              for (int j = 0; j < 8; ++j) f[j] = kf[(tg * 8 + j) * RS + dk] * __expf(cl - cum[tg * 8 + j]);
              *(u32x4*)(KDT(p) + ((size_t)cid * 128 + dk) * 64 + tg * 8) = pack8(f); }
          if (tid == 256) GLAST(p)[cid * 32] = __expf(cl); }
        __syncthreads();
        {
          float* src0 = (wid < 4 ? vf : kf) + ((wid * 2) & 7) * 16; float* src1 = src0 + 16; const float* fc = wid < 4 ? sbeta : fac;
#pragma unroll 1
          for (int bi = 0; bi < 4; ++bi) {
              f32x4 C0, C1;
#pragma unroll
              for (int r = 0; r < 4; ++r) { const float fr_ = fc[bi * 16 + g * 4 + r]; C0[r] = src0[(bi * 16 + g * 4 + r) * RS + fr] * fr_; C1[r] = src1[(bi * 16 + g * 4 + r) * RS + fr] * fr_; }
              for (int kb = 0; kb < 4 * bi; ++kb) { const float av = -Af[(bi * 16 + fr) * AS + kb * 4 + g];
                  C0 = __builtin_amdgcn_mfma_f32_16x16x4f32(av, src0[(kb * 4 + g) * RS + fr], C0, 0, 0, 0);
                  C1 = __builtin_amdgcn_mfma_f32_16x16x4f32(av, src1[(kb * 4 + g) * RS + fr], C1, 0, 0, 0); }
#pragma unroll
              for (int r = 0; r < 4; ++r) { src0[(bi * 16 + g * 4 + r) * RS + fr] = C0[r]; src1[(bi * 16 + g * 4 + r) * RS + fr] = C1[r]; }
              __builtin_amdgcn_wave_barrier();
              f32x4 D0 = {0.f, 0.f, 0.f, 0.f}, D1 = {0.f, 0.f, 0.f, 0.f};
#pragma unroll
              for (int kb = 0; kb < 4; ++kb) { const float tv = Td[(bi * 16 + fr) * TS + kb * 4 + g];
                  D0 = __builtin_amdgcn_mfma_f32_16x16x4f32(tv, src0[(bi * 16 + kb * 4 + g) * RS + fr], D0, 0, 0, 0);
                  D1 = __builtin_amdgcn_mfma_f32_16x16x4f32(tv, src1[(bi * 16 + kb * 4 + g) * RS + fr], D1, 0, 0, 0); }
              __builtin_amdgcn_wave_barrier();
#pragma unroll
              for (int r = 0; r < 4; ++r) { src0[(bi * 16 + g * 4 + r) * RS + fr] = D0[r]; src1[(bi * 16 + g * 4 + r) * RS + fr] = D1[r]; }
              __builtin_amdgcn_wave_barrier();
          }
        }
        __syncthreads();
#pragma unroll
        for (int rep = 0; rep < 4; ++rep) { const int e = tid + rep * 512; const int which = e >> 10, i = (e >> 4) & 63, c8 = (e & 15) * 8; const float* src = (which ? kf : vf) + i * RS + c8;
            const float4 x0 = *(const float4*)src, x1 = *(const float4*)(src + 4); const float fv[8] = {x0.x, x0.y, x0.z, x0.w, x1.x, x1.y, x1.z, x1.w};
            *(u32x4*)((which ? WB(p) : UB(p)) + (size_t)cid * 8192 + i * 128 + c8) = pack8(fv); }
    }
    __syncthreads();
}

__device__ void p2_moba_prep(const Params& p, unsigned char* lds) {
    bf16_t* vt = (bf16_t*)lds; float* part = (float*)(lds + 69632);
    const int tid = threadIdx.x, slot = tid >> 4, j = tid & 15;
    float qw[8], kw[8];
#pragma unroll
    for (int e = 0; e < 8; ++e) { qw[e] = p.qn_w[8 * j + e]; kw[e] = p.kn_w[8 * j + e]; }
    for (int it = blockIdx.x; it < 512; it += gridDim.x) {
        const int h = it & 7, blk = (it >> 3) & 15, b = it >> 7; const int tbase = b * SEQ + blk * 256;
        float ks[8];
#pragma unroll
        for (int e = 0; e < 8; ++e) ks[e] = 0.f;
        for (int pass = 0; pass < 8; ++pass) {
            const int tokl = pass * 32 + slot; const size_t off = (size_t)(tbase + tokl) * 1024 + h * 128 + 8 * j; const int pos = blk * 256 + tokl;
            float cs[8], sn[8];
            { const float4* rp = (const float4*)(ROPE(p) + pos * 64 + 8 * (j & 7));
#pragma unroll
              for (int e2 = 0; e2 < 4; ++e2) { const float4 t = rp[e2]; cs[2 * e2] = t.x; sn[2 * e2] = t.y; cs[2 * e2 + 1] = t.z; sn[2 * e2 + 1] = t.w; } }
#pragma unroll
            for (int s = 0; s < 2; ++s) { bf16_t* ptr = P_sec(p, 4 + s) + off; float f[8]; unpack8(*(const u32x4*)ptr, f); float ss = 0.f;
#pragma unroll
                for (int e = 0; e < 8; ++e) ss += f[e] * f[e];
                ss += __shfl_xor(ss, 1, 64); ss += __shfl_xor(ss, 2, 64); ss += __shfl_xor(ss, 4, 64); ss += __shfl_xor(ss, 8, 64);
                const float rstd = rsqrtf(ss * (1.0f / 128.0f) + EPSF); float o[8];
#pragma unroll
                for (int e = 0; e < 8; ++e) { const float y = f[e] * rstd * (s ? kw[e] : qw[e]); const float pr = __shfl_xor(y, 8, 64);
                    o[e] = (j < 8) ? (y * cs[e] - pr * sn[e]) : (y * cs[e] + pr * sn[e]); if (s) ks[e] += o[e]; }
                *(u32x4*)ptr = pack8(o); }
            *(u32x4*)(vt + tokl * 136 + 8 * j) = *(const u32x4*)(P_sec(p, 6) + off);
        }
#pragma unroll
        for (int e = 0; e < 8; ++e) part[slot * 128 + 8 * j + e] = ks[e];
        __syncthreads();
        if (tid < 128) { float s = 0.f;
#pragma unroll
            for (int q = 0; q < 32; ++q) s += part[q * 128 + tid];
            KMEAN(p)[(((size_t)b * 8 + h) * 16 + blk) * 128 + tid] = s * (1.0f / 256.0f); }
#pragma unroll
        for (int rep = 0; rep < 8; ++rep) { const int task = tid + rep * 512; const int dv = task & 127, tg = task >> 7; u32x4 w;
            unsigned short e0 = vt[(tg * 8 + 0) * 136 + dv], e1 = vt[(tg * 8 + 1) * 136 + dv], e2 = vt[(tg * 8 + 2) * 136 + dv], e3 = vt[(tg * 8 + 3) * 136 + dv];
            unsigned short e4 = vt[(tg * 8 + 4) * 136 + dv], e5 = vt[(tg * 8 + 5) * 136 + dv], e6 = vt[(tg * 8 + 6) * 136 + dv], e7 = vt[(tg * 8 + 7) * 136 + dv];
            w.x = e0 | ((unsigned)e1 << 16); w.y = e2 | ((unsigned)e3 << 16); w.z = e4 | ((unsigned)e5 << 16); w.w = e6 | ((unsigned)e7 << 16);
            *(u32x4*)(VT(p) + (((size_t)b * 8 + h) * 128 + dv) * SEQ + blk * 256 + tg * 8) = w; }
        __syncthreads();
    }
}

template <int NT>
__device__ void p3_gdn_scan(const Params& p, unsigned char* lds) {
    bf16_t* ST_s = (bf16_t*)lds; bf16_t* vT_s = (bf16_t*)(lds + NT * 4352);
    const int tid = threadIdx.x, wid = __builtin_amdgcn_readfirstlane(tid >> 6), lane = tid & 63, fr = lane & 15, g = lane >> 4;
    const int mt = wid & 3;
    for (int vb = blockIdx.x; vb < 256 / NT; vb += gridDim.x) {
        const int bh = vb / (8 / NT), slq = vb % (8 / NT);
        f32x4 Sacc[NT];
#pragma unroll
        for (int j = 0; j < NT; ++j) { Sacc[j] = (f32x4){0.f, 0.f, 0.f, 0.f}; u32x2 z; z.x = 0u; z.y = 0u; *(u32x2*)(ST_s + (j * 16 + fr) * 136 + wid * 16 + g * 4) = z; }
        const bf16_t* abase = (wid < 4 ? WB(p) : QDB(p)) + (mt * 16 + fr) * 128 + g * 8;
        const bf16_t* kbase = KDT(p) + (wid * 16 + fr) * 64 + g * 8;
        const bf16_t* qkbase = QKB(p) + (mt * 16 + fr) * 64 + g * 8;
        const bf16_t* ubase = UB(p) + (mt * 16 + g * 4) * 128 + slq * NT * 16 + fr;
        u32x4 a4A[4], a4B[4], kAA[2], kAB[2], qkA[2], qkB[2]; bf16_t uvA[NT][4], uvB[NT][4]; float glA, glB;
#define SLOADA(cid_) do { const int _cid = (cid_); const bf16_t* _ab = abase + (size_t)_cid * 8192; \
            _Pragma("unroll") for (int ks = 0; ks < 4; ++ks) a4A[ks] = *(const u32x4*)(_ab + ks * 32); \
            kAA[0] = *(const u32x4*)(kbase + (size_t)_cid * 8192); kAA[1] = *(const u32x4*)(kbase + (size_t)_cid * 8192 + 32); glA = GLAST(p)[_cid * 32]; \
            qkA[0] = *(const u32x4*)(qkbase + (size_t)_cid * 4096); qkA[1] = *(const u32x4*)(qkbase + (size_t)_cid * 4096 + 32); \
            _Pragma("unroll") for (int j = 0; j < NT; ++j) _Pragma("unroll") for (int r = 0; r < 4; ++r) uvA[j][r] = ubase[(size_t)_cid * 8192 + r * 128 + j * 16]; } while (0)
#define SLOADB(cid_) do { const int _cid = (cid_); const bf16_t* _ab = abase + (size_t)_cid * 8192; \
            _Pragma("unroll") for (int ks = 0; ks < 4; ++ks) a4B[ks] = *(const u32x4*)(_ab + ks * 32); \
            kAB[0] = *(const u32x4*)(kbase + (size_t)_cid * 8192); kAB[1] = *(const u32x4*)(kbase + (size_t)_cid * 8192 + 32); glB = GLAST(p)[_cid * 32]; \
            qkB[0] = *(const u32x4*)(qkbase + (size_t)_cid * 4096); qkB[1] = *(const u32x4*)(qkbase + (size_t)_cid * 4096 + 32); \
            _Pragma("unroll") for (int j = 0; j < NT; ++j) _Pragma("unroll") for (int r = 0; r < 4; ++r) uvB[j][r] = ubase[(size_t)_cid * 8192 + r * 128 + j * 16]; } while (0)
        SLOADA(bh * 64); SLOADB(bh * 64 + 1);
        __syncthreads();
#pragma unroll 1
        for (int n = 0; n < 64; n += 2) {
            { const int nn = n;
            f32x4 acc[NT];
#pragma unroll
            for (int j = 0; j < NT; ++j) { acc[j] = (f32x4){0.f, 0.f, 0.f, 0.f};
#pragma unroll
                for (int ks = 0; ks < 4; ++ks) acc[j] = MFMA16(as_bf8(a4A[ks]), as_bf8(*(const u32x4*)(ST_s + (j * 16 + fr) * 136 + g * 8 + ks * 32)), acc[j]); }
            if (wid < 4) {
#pragma unroll
                for (int j = 0; j < NT; ++j) { float vn[4];
#pragma unroll
                    for (int r = 0; r < 4; ++r) vn[r] = bf2f(uvA[j][r]) - acc[j][r];
                    u32x2 w; w.x = cvt_pk_bf16(vn[0], vn[1]); w.y = cvt_pk_bf16(vn[2], vn[3]); *(u32x2*)(vT_s + (j * 16 + fr) * 72 + mt * 16 + g * 4) = w; } }
            const float gl = glA; const u32x4 k0 = kAA[0], k1 = kAA[1], q0 = qkA[0], q1 = qkA[1];
            SLOADA(bh * 64 + (nn + 2 < 64 ? nn + 2 : 63));
            __syncthreads();
#pragma unroll
            for (int j = 0; j < NT; ++j) {
                const bf16x8 vf0 = as_bf8(*(const u32x4*)(vT_s + (j * 16 + fr) * 72 + g * 8)), vf1 = as_bf8(*(const u32x4*)(vT_s + (j * 16 + fr) * 72 + 32 + g * 8));
                if (wid >= 4) {
                    acc[j] = MFMA16(as_bf8(q0), vf0, acc[j]); acc[j] = MFMA16(as_bf8(q1), vf1, acc[j]);
                    float* op = OGDN(p) + ((size_t)(bh * 8 + slq * NT + j) * SEQ + nn * 64 + mt * 16 + g * 4) * 16 + fr;
#pragma unroll
                    for (int r = 0; r < 4; ++r) op[r * 16] = acc[j][r];
                }
                Sacc[j] *= gl;
                Sacc[j] = MFMA16(as_bf8(k0), vf0, Sacc[j]); Sacc[j] = MFMA16(as_bf8(k1), vf1, Sacc[j]);
                { u32x2 w; w.x = cvt_pk_bf16(Sacc[j][0], Sacc[j][1]); w.y = cvt_pk_bf16(Sacc[j][2], Sacc[j][3]); *(u32x2*)(ST_s + (j * 16 + fr) * 136 + wid * 16 + g * 4) = w; }
            }
            __syncthreads();
            }
            { const int nn = (n + 1);
            f32x4 acc[NT];
#pragma unroll
            for (int j = 0; j < NT; ++j) { acc[j] = (f32x4){0.f, 0.f, 0.f, 0.f};
#pragma unroll
                for (int ks = 0; ks < 4; ++ks) acc[j] = MFMA16(as_bf8(a4B[ks]), as_bf8(*(const u32x4*)(ST_s + (j * 16 + fr) * 136 + g * 8 + ks * 32)), acc[j]); }
            if (wid < 4) {
#pragma unroll
                for (int j = 0; j < NT; ++j) { float vn[4];
#pragma unroll
                    for (int r = 0; r < 4; ++r) vn[r] = bf2f(uvB[j][r]) - acc[j][r];
                    u32x2 w; w.x = cvt_pk_bf16(vn[0], vn[1]); w.y = cvt_pk_bf16(vn[2], vn[3]); *(u32x2*)(vT_s + (j * 16 + fr) * 72 + mt * 16 + g * 4) = w; } }
            const float gl = glB; const u32x4 k0 = kAB[0], k1 = kAB[1], q0 = qkB[0], q1 = qkB[1];
            SLOADB(bh * 64 + (nn + 2 < 64 ? nn + 2 : 63));
            __syncthreads();
#pragma unroll
            for (int j = 0; j < NT; ++j) {
                const bf16x8 vf0 = as_bf8(*(const u32x4*)(vT_s + (j * 16 + fr) * 72 + g * 8)), vf1 = as_bf8(*(const u32x4*)(vT_s + (j * 16 + fr) * 72 + 32 + g * 8));
                if (wid >= 4) {
                    acc[j] = MFMA16(as_bf8(q0), vf0, acc[j]); acc[j] = MFMA16(as_bf8(q1), vf1, acc[j]);
                    float* op = OGDN(p) + ((size_t)(bh * 8 + slq * NT + j) * SEQ + nn * 64 + mt * 16 + g * 4) * 16 + fr;
#pragma unroll
                    for (int r = 0; r < 4; ++r) op[r * 16] = acc[j][r];
                }
                Sacc[j] *= gl;
                Sacc[j] = MFMA16(as_bf8(k0), vf0, Sacc[j]); Sacc[j] = MFMA16(as_bf8(k1), vf1, Sacc[j]);
                { u32x2 w; w.x = cvt_pk_bf16(Sacc[j][0], Sacc[j][1]); w.y = cvt_pk_bf16(Sacc[j][2], Sacc[j][3]); *(u32x2*)(ST_s + (j * 16 + fr) * 136 + wid * 16 + g * 4) = w; }
            }
            __syncthreads();
            }
        }
    }
#undef SLOADA
#undef SLOADB
    if ((int)blockIdx.x < 256 / NT) {
        asm volatile("s_waitcnt vmcnt(0) lgkmcnt(0)" ::: "memory");
        __syncthreads();
        if (threadIdx.x < 64) { __builtin_amdgcn_fence(__ATOMIC_RELEASE, "agent"); asm volatile("s_waitcnt vmcnt(0)" ::: "memory");
            if (threadIdx.x == 0) { int nit = 0; for (int vb = blockIdx.x; vb < 256 / NT; vb += gridDim.x) ++nit; __hip_atomic_fetch_add(BARCTR(p) + 32, (unsigned)nit, __ATOMIC_RELAXED, __HIP_MEMORY_SCOPE_AGENT); } }
    }
}

__device__ void p3_moba_attn(const Params& p, unsigned char* lds) {
    const int tid = threadIdx.x, wid = __builtin_amdgcn_readfirstlane(tid >> 6), lane = tid & 63, fr = lane & 15, g = lane >> 4;
    const float scale2 = 0.08838834764831845f * 1.4426950408889634f;
    const bf16_t* MQ = P_sec(p, 4); const bf16_t* MK = P_sec(p, 5); const bf16_t* MZ = P_sec(p, 7);
    bf16_t* Kb = (bf16_t*)lds;
    bf16_t* Vb = (bf16_t*)(lds + 34816);
    float* gsc = (float*)(lds + 71680) + wid * 512;
    float B2;
    { float mq = fmaxf(fabsf(p.qn_w[lane]), fabsf(p.qn_w[lane + 64])), mk = fmaxf(fabsf(p.kn_w[lane]), fabsf(p.kn_w[lane + 64]));
#pragma unroll
      for (int d = 32; d >= 1; d >>= 1) { mq = fmaxf(mq, __shfl_xor(mq, d, 64)); mk = fmaxf(mk, __shfl_xor(mk, d, 64)); }
      B2 = 128.0f * mq * mk * scale2 * 1.02f; }
    int* slot = (int*)(lds + 126976); unsigned* qctr = BARCTR(p) + 16;
    for (;;) {
        __syncthreads();
        if (tid == 0) *slot = (int)__hip_atomic_fetch_add(qctr, 1u, __ATOMIC_RELAXED, __HIP_MEMORY_SCOPE_AGENT);
        __syncthreads();
        const int item = __builtin_amdgcn_readfirstlane(*slot);
        if (item >= 512) break;
        const int bh = item & 31, b = bh >> 3, h = bh & 7; const size_t tb = (size_t)b * SEQ;
        const bf16_t* vtb = VT(p) + ((size_t)bh * 128) * SEQ;
        {
            const int blk = 15 - (item >> 5); const int qoff = wid * 32, q0 = blk * 256 + qoff;
            bf16x8 qf[2][4];
#pragma unroll
            for (int t = 0; t < 2; ++t)
#pragma unroll
                for (int ks = 0; ks < 4; ++ks) qf[t][ks] = as_bf8(*(const u32x4*)(MQ + (tb + q0 + t * 16 + fr) * 1024 + h * 128 + ks * 32 + g * 8));
            unsigned mymask = (1u << blk) - 1u;
            if (blk > 3) {
                f32x4 ga0 = {0.f, 0.f, 0.f, 0.f}, ga1 = {0.f, 0.f, 0.f, 0.f};
                const float* km = KMEAN(p) + ((size_t)bh * 16 + fr) * 128 + g * 8;
#pragma unroll
                for (int ks = 0; ks < 4; ++ks) { const float4 x0 = *(const float4*)(km + ks * 32), x1 = *(const float4*)(km + ks * 32 + 4);
                    const float xs[8] = {x0.x, x0.y, x0.z, x0.w, x1.x, x1.y, x1.z, x1.w}; float hi[8], lo[8];
#pragma unroll
                    for (int e = 0; e < 8; ++e) { hi[e] = __uint_as_float(__float_as_uint(xs[e]) & 0xffff0000u); lo[e] = xs[e] - hi[e]; }
                    const bf16x8 khi = as_bf8(pack8(hi)), klo = as_bf8(pack8(lo));
                    ga0 = MFMA16(khi, qf[0][ks], ga0); ga0 = MFMA16(klo, qf[0][ks], ga0); ga1 = MFMA16(khi, qf[1][ks], ga1); ga1 = MFMA16(klo, qf[1][ks], ga1); }
#pragma unroll
                for (int r = 0; r < 4; ++r) { gsc[(g * 4 + r) * 32 + fr] = ga0[r]; gsc[(g * 4 + r) * 32 + 16 + fr] = ga1[r]; }
                __builtin_amdgcn_wave_barrier();
                float ga[16];
#pragma unroll
                for (int jb = 0; jb < 16; ++jb) ga[jb] = gsc[jb * 32 + (lane & 31)];
                __builtin_amdgcn_wave_barrier();
                unsigned m = 0u;
#pragma unroll
                for (int s3 = 0; s3 < 3; ++s3) { float best = -INFINITY; int bi = -1;
#pragma unroll
                    for (int jb = 0; jb < 16; ++jb) { const bool ok = (jb < blk) && !((m >> jb) & 1u); if (ok && (ga[jb] > best || bi < 0)) { best = ga[jb]; bi = jb; } }
                    if (bi >= 0) m |= 1u << bi; }
                mymask = m;
            }
            unsigned um = mymask, am = mymask;
#pragma unroll
            for (int d = 16; d >= 1; d >>= 1) { um |= __shfl_xor(um, d, 64); am &= __shfl_xor(am, d, 64); }
            unsigned qmask[2]; qmask[0] = __shfl(mymask, fr, 64); qmask[1] = __shfl(mymask, 16 + fr, 64);
            f32x4 O[2][8];
#pragma unroll
            for (int t = 0; t < 2; ++t)
#pragma unroll
                for (int d = 0; d < 8; ++d) O[t][d] = (f32x4){0.f, 0.f, 0.f, 0.f};
            float lrun[2] = {0.f, 0.f};
            const int nst = (blk + 1) * 4;
            const bf16_t* kg = MK + (tb + (tid >> 3)) * 1024 + h * 128 + (tid & 7) * 16; const bf16_t* vg = vtb + (size_t)(tid >> 2) * SEQ + (tid & 3) * 16;
            bf16_t* kl = Kb + (tid >> 3) * 136 + (tid & 7) * 16; bf16_t* vl = Vb + (tid >> 2) * 72 + (tid & 3) * 16;
            u32x4 rk0 = *(const u32x4*)kg, rk1 = *(const u32x4*)(kg + 8), rv0 = *(const u32x4*)vg, rv1 = *(const u32x4*)(vg + 8);
            for (int st = 0; st < nst; ++st) {
                const int buf = st & 1;
                *(u32x4*)(kl + buf * 8704) = rk0; *(u32x4*)(kl + buf * 8704 + 8) = rk1; *(u32x4*)(vl + buf * 9216) = rv0; *(u32x4*)(vl + buf * 9216 + 8) = rv1;
                __syncthreads();
                if (st + 1 < nst) { const size_t ko = (size_t)(st + 1) * 64; rk0 = *(const u32x4*)(kg + ko * 1024); rk1 = *(const u32x4*)(kg + ko * 1024 + 8); rv0 = *(const u32x4*)(vg + ko); rv1 = *(const u32x4*)(vg + ko + 8); }
                const int jb = st >> 2; const bool own = (jb == blk);
                if (!own && !((um >> jb) & 1u)) continue;
                const bf16_t* Ks = Kb + buf * 8704; const bf16_t* Vs = Vb + buf * 9216;
#pragma unroll 1
                for (int sub = 0; sub < 2; ++sub) {
                    const int kin = (st & 3) * 64 + sub * 32;
                    if (own && kin > qoff + 31) break;
                    const bool needmask = own ? (kin + 31 > qoff) : !((am >> jb) & 1u);
                    f32x4 sc[2][2];
#pragma unroll
                    for (int t = 0; t < 2; ++t)
#pragma unroll
                        for (int kt = 0; kt < 2; ++kt) sc[t][kt] = (f32x4){0.f, 0.f, 0.f, 0.f};
#pragma unroll
                    for (int kt = 0; kt < 2; ++kt) { const bf16_t* kp = Ks + (sub * 32 + kt * 16 + fr) * 136 + g * 8;
#pragma unroll
                        for (int ks = 0; ks < 4; ++ks) { const bf16x8 kfr = as_bf8(*(const u32x4*)(kp + ks * 32));
                            sc[0][kt] = MFMA16(kfr, qf[0][ks], sc[0][kt]); sc[1][kt] = MFMA16(kfr, qf[1][ks], sc[1][kt]); } }
                    bf16x8 pf[2];
#pragma unroll
                    for (int t = 0; t < 2; ++t) {
                        float pv[8];
#pragma unroll
                        for (int kt = 0; kt < 2; ++kt)
#pragma unroll
                            for (int r = 0; r < 4; ++r) pv[kt * 4 + r] = __builtin_amdgcn_exp2f(__builtin_fmaf(sc[t][kt][r], scale2, -B2));
                        if (needmask) {
                            const bool sel = own || ((qmask[t] >> jb) & 1u);
#pragma unroll
                            for (int kt = 0; kt < 2; ++kt)
#pragma unroll
                                for (int r = 0; r < 4; ++r) { bool ok = sel; if (own) ok = (kin + kt * 16 + g * 4 + r) <= (qoff + t * 16 + fr); pv[kt * 4 + r] = ok ? pv[kt * 4 + r] : 0.f; } }
                        lrun[t] += ((pv[0] + pv[1]) + (pv[2] + pv[3])) + ((pv[4] + pv[5]) + (pv[6] + pv[7]));
                        pf[t] = as_bf8(pack8(pv));
                    }
#pragma unroll
                    for (int d = 0; d < 8; ++d) { const bf16_t* vp = Vs + (d * 16 + fr) * 72 + sub * 32 + g * 4;
                        const u32x2 v0 = *(const u32x2*)vp, v1 = *(const u32x2*)(vp + 16); u32x4 vv; vv.x = v0.x; vv.y = v0.y; vv.z = v1.x; vv.w = v1.y; const bf16x8 vfr = as_bf8(vv);
                        O[0][d] = MFMA16(vfr, pf[0], O[0][d]); O[1][d] = MFMA16(vfr, pf[1], O[1][d]); }
                }
            }
#pragma unroll
            for (int t = 0; t < 2; ++t) { float l = lrun[t]; l += __shfl_xor(l, 16, 64); l += __shfl_xor(l, 32, 64); const float inv = __builtin_amdgcn_rcpf(l);
                const size_t ro = (tb + q0 + t * 16 + fr) * 1024 + h * 128 + g * 4;
#pragma unroll
                for (int d = 0; d < 8; ++d) { const u32x2 zz = *(const u32x2*)(MZ + ro + d * 16); const float z0 = bflo(zz.x), z1 = bfhi(zz.x), z2 = bflo(zz.y), z3 = bfhi(zz.y);
                    u32x2 w; w.x = cvt_pk_bf16(O[t][d][0] * inv * siluf_(z0), O[t][d][1] * inv * siluf_(z1)); w.y = cvt_pk_bf16(O[t][d][2] * inv * siluf_(z2), O[t][d][3] * inv * siluf_(z3));
                    *(u32x2*)(OB(p) + ro + d * 16) = w; } }
        }
    }
    __syncthreads();
}

__device__ void p4_gdn_post(const Params& p) {
    const int j = threadIdx.x & 15; const bf16_t* GZ = P_sec(p, 3);
    float nw[8];
#pragma unroll
    for (int e = 0; e < 8; ++e) nw[e] = p.gdn_norm_w[8 * j + e];
    for (int pr = blockIdx.x * 32 + (threadIdx.x >> 4); pr < NTOK * 8; pr += gridDim.x * 32) {
        const size_t off = (size_t)pr * 128 + 8 * j;
        const int tok = pr >> 3, hh = pr & 7; const size_t goff = ((((size_t)(tok >> 12) * 8 + hh) * 8 + (j >> 1)) * SEQ + (tok & 4095)) * 16 + (j & 1) * 8;
        const float4 a = *(const float4*)(OGDN(p) + goff), c = *(const float4*)(OGDN(p) + goff + 4);
        float f[8] = {a.x, a.y, a.z, a.w, c.x, c.y, c.z, c.w}; float ss = 0.f;
#pragma unroll
        for (int e = 0; e < 8; ++e) ss += f[e] * f[e];
        ss += __shfl_xor(ss, 1, 64); ss += __shfl_xor(ss, 2, 64); ss += __shfl_xor(ss, 4, 64); ss += __shfl_xor(ss, 8, 64);
        const float rstd = rsqrtf(ss * (1.0f / 128.0f) + EPSF); float z[8]; unpack8(*(const u32x4*)(GZ + off), z); float o[8];
#pragma unroll
        for (int e = 0; e < 8; ++e) o[e] = f[e] * rstd * nw[e] * siluf_(z[e]);
        *(u32x4*)(OA(p) + off) = pack8(o);
    }
}

__device__ void p4_gdn_post_items(const Params& p, unsigned char* lds, int n_scan_items) {
    const int tid = threadIdx.x, j = tid & 15; const bf16_t* GZ = P_sec(p, 3);
    int* slot = (int*)(lds + 126976); unsigned* done = BARCTR(p) + 32; unsigned* q2 = BARCTR(p) + 48;
    if (tid < 64) { if (tid == 0) { while (__hip_atomic_load(done, __ATOMIC_RELAXED, __HIP_MEMORY_SCOPE_AGENT) < (unsigned)n_scan_items) __builtin_amdgcn_s_sleep(2); }
        __builtin_amdgcn_fence(__ATOMIC_ACQUIRE, "agent"); asm volatile("s_waitcnt vmcnt(0)" ::: "memory"); }
    float nw[8];
#pragma unroll
    for (int e = 0; e < 8; ++e) nw[e] = p.gdn_norm_w[8 * j + e];
    for (;;) {
        __syncthreads();
        if (tid == 0) *slot = (int)__hip_atomic_fetch_add(q2, 1u, __ATOMIC_RELAXED, __HIP_MEMORY_SCOPE_AGENT);
        __syncthreads();
        const int item = __builtin_amdgcn_readfirstlane(*slot);
        if (item >= 512) break;
#pragma unroll 2
        for (int k = 0; k < 8; ++k) { const int pr = item * 256 + k * 32 + (tid >> 4);
            const size_t off = (size_t)pr * 128 + 8 * j;
            const int tok = pr >> 3, hh = pr & 7; const size_t goff = ((((size_t)(tok >> 12) * 8 + hh) * 8 + (j >> 1)) * SEQ + (tok & 4095)) * 16 + (j & 1) * 8;
            const float4 a = *(const float4*)(OGDN(p) + goff), c = *(const float4*)(OGDN(p) + goff + 4);
            float f[8] = {a.x, a.y, a.z, a.w, c.x, c.y, c.z, c.w}; float ss = 0.f;
#pragma unroll
            for (int e = 0; e < 8; ++e) ss += f[e] * f[e];
            ss += __shfl_xor(ss, 1, 64); ss += __shfl_xor(ss, 2, 64); ss += __shfl_xor(ss, 4, 64); ss += __shfl_xor(ss, 8, 64);
            const float rstd = rsqrtf(ss * (1.0f / 128.0f) + EPSF); float z[8]; unpack8(*(const u32x4*)(GZ + off), z); float o[8];
#pragma unroll
            for (int e = 0; e < 8; ++e) o[e] = f[e] * rstd * nw[e] * siluf_(z[e]);
            *(u32x4*)(OA(p) + off) = pack8(o); }
    }
}

__device__ __forceinline__ void grid_barrier(unsigned* ctr, unsigned& target) {
    asm volatile("s_waitcnt vmcnt(0) lgkmcnt(0)" ::: "memory");
    __syncthreads();
    target += gridDim.x;
    if (threadIdx.x < 64) {
        __builtin_amdgcn_fence(__ATOMIC_RELEASE, "agent");
        asm volatile("s_waitcnt vmcnt(0)" ::: "memory");
        if (threadIdx.x == 0) {
            __hip_atomic_fetch_add(ctr, 1u, __ATOMIC_RELAXED, __HIP_MEMORY_SCOPE_AGENT);
            while (__hip_atomic_load(ctr, __ATOMIC_RELAXED, __HIP_MEMORY_SCOPE_AGENT) < target) __builtin_amdgcn_s_sleep(4);
        }
        __builtin_amdgcn_fence(__ATOMIC_ACQUIRE, "agent");
        asm volatile("s_waitcnt vmcnt(0)" ::: "memory");
    }
    __syncthreads();
}

__device__ void dbg_dump(const Params& p, const bf16_t* a, const bf16_t* b) {
    for (size_t i = (size_t)blockIdx.x * 512 + threadIdx.x; i < (size_t)NTOK * 256; i += (size_t)gridDim.x * 512) {
        const size_t r = i >> 8; const int c8 = (int)(i & 255) * 8; const bf16_t* src = (c8 < 1024 ? a : b) + r * 1024 + (c8 & 1023);
        float f[8]; unpack8(*(const u32x4*)src, f);
        *(float4*)(p.out + r * 2048 + c8) = make_float4(f[0], f[1], f[2], f[3]); *(float4*)(p.out + r * 2048 + c8 + 4) = make_float4(f[4], f[5], f[6], f[7]); }
}

__global__ void __launch_bounds__(512, 2) fwd_megakernel(Params p) {
    extern __shared__ __attribute__((aligned(16))) unsigned char shm[];
    cg::grid_group grid = cg::this_grid();
    unsigned* bctr = BARCTR(p); unsigned btarget = 0u;
    PG8_LAS unsigned char* lds = (PG8_LAS unsigned char*)shm;
    const int G = (int)gridDim.x, c = (int)blockIdx.x;
#ifndef PHM
#define PHM 0xff
#endif
    p0_rope_table(p);
    p0_rows(p);
    p0_transposes(p, (float*)shm);
    grid_barrier(bctr, btarget);
    { p1_skinny(p, (float*)shm);
    { pg8::StaticOrder S; S.init(NTOK, 12288, G, c); pg8::Gemm gm{HB(p), WinT(p), NTOK, 12288, 2048, HB(p), WinT(p)}; Epi1 E{(bf16_t*)p.ws};
      pg8::gemm_phase<Epi1, pg8::StaticOrder, false>(lds, gm, S, E, nullptr); } }
    grid_barrier(bctr, btarget);
    p2_gdn_prep(p, shm);
    p2_moba_prep(p, shm);
    grid_barrier(bctr, btarget);
#if DBG == 2
    dbg_dump(p, P_sec(p, 4), P_sec(p, 5)); return;
#elif DBG == 3
    dbg_dump(p, P_sec(p, 0), P_sec(p, 3)); return;
#elif DBG == 4 || DBG == 5
    { const u32x4* s0 = (const u32x4*)(DBG == 4 ? UB(p) : QDB(p)); const u32x4* s1 = (const u32x4*)(DBG == 4 ? WB(p) : KDT(p)); u32x4* d0 = (u32x4*)OB(p); u32x4* d1 = (u32x4*)VT(p);
      for (size_t i = (size_t)blockIdx.x * 512 + threadIdx.x; i < (size_t)2097152; i += (size_t)gridDim.x * 512) { d0[i] = s0[i]; d1[i] = s1[i]; }
      grid_barrier(bctr, btarget); dbg_dump(p, OB(p), VT(p)); return; }
#endif
    p3_gdn_scan<SCAN_NT>(p, shm);
    p3_moba_attn(p, shm);
    p4_gdn_post_items(p, shm, 256 / SCAN_NT);
    grid_barrier(bctr, btarget);
#if DBG == 1
    dbg_dump(p, OA(p), OB(p)); return;
#elif DBG == 7
    dbg_dump(p, OA(p), OA(p)); return;
#elif DBG == 8
    dbg_dump(p, OB(p), OB(p)); return;
#endif
    { pg8::StaticOrder S; S.init(NTOK, 2048, G, c);
      PairOrder PO; PO.base = S; pg8::Gemm gm{OA(p), WgT(p), NTOK, 2048, 1024, OB(p), WmT(p)}; Epi2 E{MERGED(p), P_sec(p, 8), P_sec(p, 10)};
      pg8::gemm_phase<Epi2, PairOrder, false>(lds, gm, PO, E, nullptr); }
    grid_barrier(bctr, btarget);
    { pg8::StaticOrder S; S.init(NTOK, 2048, G, c); pg8::Gemm gm{MERGED(p), WoT(p), NTOK, 2048, 2048, MERGED(p), WoT(p)}; Epi3 E{p.out, p.x};
      pg8::gemm_phase<Epi3, pg8::StaticOrder, false>(lds, gm, S, E, nullptr); }
}

extern "C" void kernel_launch(void* const* d_in, const int* in_sizes, int n_in, void* d_out, int out_size, void* d_ws, size_t ws_size, hipStream_t stream) {
    constexpr size_t kDynLds = 131072;
    static int grid_blocks = 0;
    if (!grid_blocks) {
        int dev = 0, cus = 0, per_cu = 0;
        hipGetDevice(&dev);
        hipDeviceGetAttribute(&cus, hipDeviceAttributeMultiprocessorCount, dev);
        hipFuncSetAttribute((const void*)fwd_megakernel, hipFuncAttributeMaxDynamicSharedMemorySize, (int)kDynLds);
        hipOccupancyMaxActiveBlocksPerMultiprocessor(&per_cu, fwd_megakernel, 512, kDynLds);
        if (per_cu < 1) per_cu = 1;
        grid_blocks = cus * per_cu;
        if (grid_blocks > 256) grid_blocks = 256;
    }
    Params p{};
    p.x = (const float*)d_in[0]; p.norm_w = (const float*)d_in[1]; p.w_in = (const float*)d_in[2]; p.conv_w = (const float*)d_in[3];
    p.a_log = (const float*)d_in[4]; p.dt_bias = (const float*)d_in[5]; p.gdn_norm_w = (const float*)d_in[6]; p.qn_w = (const float*)d_in[7]; p.kn_w = (const float*)d_in[8];
    p.w_out_gdn = (const float*)d_in[9]; p.w_out_moba = (const float*)d_in[10]; p.w_o = (const float*)d_in[11];
    p.out = (float*)d_out; p.ws = (unsigned char*)d_ws;
    hipMemsetAsync((unsigned char*)d_ws + (size_t)482 * 1048576, 0, 256, stream);
    void* args[] = {&p};
    hipError_t e = hipLaunchCooperativeKernel((void*)fwd_megakernel, dim3(grid_blocks), dim3(512), args, kDynLds, stream);
    if (e != hipSuccess) fprintf(stderr, "cooperative launch failed: %s (grid %d)\n", hipGetErrorString(e), grid_blocks);
}
```
